# Optimizing an MI355X kernel written in HIP

```python
import jax, jax.numpy as jnp
from jax import lax
import numpy as np

D_MODEL = 4096
BATCH = 2
SEQ = 8192
DEPTH = 1

MIX_WIDTH = D_MODEL
HEAD_DIM = 128
ATTN_WIDTH = MIX_WIDTH // 2
CONV_WIDTH = MIX_WIDTH - ATTN_WIDTH
N_Q_HEADS = ATTN_WIDTH // HEAD_DIM
N_KV_HEADS = 4
GQA_GROUP = N_Q_HEADS // N_KV_HEADS
KV_WIDTH = N_KV_HEADS * HEAD_DIM
CONV_K = 3
IN_COLS = ATTN_WIDTH + 2 * KV_WIDTH + 3 * CONV_WIDTH
SPLIT_POINTS = (ATTN_WIDTH,
                ATTN_WIDTH + KV_WIDTH,
                ATTN_WIDTH + 2 * KV_WIDTH,
                ATTN_WIDTH + 2 * KV_WIDTH + CONV_WIDTH,
                ATTN_WIDTH + 2 * KV_WIDTH + 2 * CONV_WIDTH)
GRID_W = 64
ROPE_THETA = 10000.0
Q_BLOCK = 128
N_KEYS = 128
N_EXPERTS = N_KEYS * N_KEYS
PEER_HEADS = 8
PEER_TOPK = 16
PEER_KEY_DIM = 128
PEER_QUERY_DIM = 2 * PEER_KEY_DIM
PEER_BLOCK = 128
EPS = 1e-6

kernel_name = "hymba_conv_axialgqa_peer_encoder_block"


def rms_norm(x, g):
    x32 = x.astype(jnp.float32)
    y = x32 * lax.rsqrt(jnp.mean(x32 * x32, axis=-1, keepdims=True) + EPS)
    return (y * g.astype(jnp.float32)).astype(x.dtype)


def axial_angles(seq_len):
    rows = seq_len // GRID_W
    row = jnp.repeat(jnp.arange(rows, dtype=jnp.float32), GRID_W)
    col = jnp.tile(jnp.arange(GRID_W, dtype=jnp.float32), rows)
    half = HEAD_DIM // 2
    inv = ROPE_THETA ** (-jnp.arange(0, half, 2, dtype=jnp.float32) / half)
    return row[:, None] * inv, col[:, None] * inv


def rotate(x, ang):
    cos = jnp.cos(ang)[:, None, :].astype(x.dtype)
    sin = jnp.sin(ang)[:, None, :].astype(x.dtype)
    x1, x2 = jnp.split(x, 2, axis=-1)
    return jnp.concatenate([x1 * cos - x2 * sin, x1 * sin + x2 * cos], axis=-1)


def apply_axial_rope(x, ang_row, ang_col):
    x_row, x_col = jnp.split(x, 2, axis=-1)
    return jnp.concatenate([rotate(x_row, ang_row), rotate(x_col, ang_col)], axis=-1)


def bidir_gqa(q, k, v):
    b, s, _, _ = q.shape
    nb = s // Q_BLOCK
    qb = q.reshape(b, nb, Q_BLOCK, N_KV_HEADS, GQA_GROUP, HEAD_DIM).transpose(1, 0, 2, 3, 4, 5)
    scale = HEAD_DIM ** -0.5

    def block(qi):
        sc = jnp.einsum('bqkgd,bskd->bkgqs', qi, k, preferred_element_type=jnp.float32) * scale
        p = jax.nn.softmax(sc, axis=-1).astype(v.dtype)
        return jnp.einsum('bkgqs,bskd->bqkgd', p, v)

    o = lax.map(block, qb)
    return o.transpose(1, 0, 2, 3, 4, 5).reshape(b, s, ATTN_WIDTH)


def short_conv(u, w):
    up = jnp.pad(u, ((0, 0), (1, 1), (0, 0)))
    return up[:, :-2] * w[0] + up[:, 1:-1] * w[1] + up[:, 2:] * w[2]


def hybrid_mixer(h, w_in, q_norm_g, k_norm_g, conv_w, attn_out_g, conv_out_g, w_out):
    b, s, _ = h.shape
    proj = h @ w_in
    q, k, v, cx, gb, gc = jnp.split(proj, SPLIT_POINTS, axis=-1)
    q = rms_norm(q.reshape(b, s, N_Q_HEADS, HEAD_DIM), q_norm_g)
    k = rms_norm(k.reshape(b, s, N_KV_HEADS, HEAD_DIM), k_norm_g)
    v = v.reshape(b, s, N_KV_HEADS, HEAD_DIM)
    ang_row, ang_col = axial_angles(s)
    q = apply_axial_rope(q, ang_row, ang_col)
    k = apply_axial_rope(k, ang_row, ang_col)
    attn = bidir_gqa(q, k, v)
    conv = gb * short_conv(gc * cx, conv_w)
    y = jnp.concatenate([rms_norm(attn, attn_out_g), rms_norm(conv, conv_out_g)], axis=-1)
    return y @ w_out


def peer_ffn(h, w_query, sub_keys, w_down, w_up):
    b, s, d = h.shape
    q = (h @ w_query).reshape(b, s, PEER_HEADS, 2, PEER_KEY_DIM)
    sc = jnp.einsum('bshpd,hpnd->bshpn', q, sub_keys)
    v_top, i_top = lax.top_k(sc, PEER_TOPK)
    cand_s = (v_top[..., 0, :, None] + v_top[..., 1, None, :]).reshape(
        b, s, PEER_HEADS, PEER_TOPK * PEER_TOPK)
    cand_i = (i_top[..., 0, :, None] * N_KEYS + i_top[..., 1, None, :]).reshape(
        b, s, PEER_HEADS, PEER_TOPK * PEER_TOPK)
    best_s, pos = lax.top_k(cand_s, PEER_TOPK)
    idx = jnp.take_along_axis(cand_i, pos, axis=-1)
    gate = jax.nn.softmax(best_s.astype(jnp.float32), axis=-1).astype(h.dtype)
    nblk = (b * s) // PEER_BLOCK
    xs = h.reshape(nblk, PEER_BLOCK, d)
    idx = idx.reshape(nblk, PEER_BLOCK, PEER_HEADS, PEER_TOPK)
    gate = gate.reshape(nblk, PEER_BLOCK, PEER_HEADS, PEER_TOPK)

    def block(args):
        xb, ib, gbk = args
        u = jnp.take(w_down, ib, axis=0)
        a = jax.nn.gelu(jnp.einsum('thkd,td->thk', u, xb), approximate=False) * gbk
        vv = jnp.take(w_up, ib, axis=0)
        return jnp.einsum('thk,thkd->td', a, vv)

    out = lax.map(block, (xs, idx, gate))
    return out.reshape(b, s, d)


def setup_inputs(seed: int = 0) -> dict:
    key = jax.random.key(seed)
    ks = jax.random.split(key, 16)
    f32 = jnp.float32

    def nrm(k, shape, scale):
        return jax.random.normal(k, shape, f32) * scale

    def gain(k, shape):
        return 1.0 + 0.02 * jax.random.normal(k, shape, f32)

    return {
        "x": nrm(ks[0], (BATCH, SEQ, D_MODEL), 1.0),
        "norm_mix_g": gain(ks[1], (DEPTH, D_MODEL)),
        "w_in": nrm(ks[2], (DEPTH, D_MODEL, IN_COLS), D_MODEL ** -0.5),
        "q_norm_g": gain(ks[3], (DEPTH, HEAD_DIM)),
        "k_norm_g": gain(ks[4], (DEPTH, HEAD_DIM)),
        "conv_w": nrm(ks[5], (DEPTH, CONV_K, CONV_WIDTH), CONV_K ** -0.5),
        "attn_out_g": gain(ks[6], (DEPTH, ATTN_WIDTH)),
        "conv_out_g": gain(ks[7], (DEPTH, CONV_WIDTH)),
        "w_out": nrm(ks[8], (DEPTH, MIX_WIDTH, D_MODEL), MIX_WIDTH ** -0.5),
        "norm_ffn_g": gain(ks[9], (DEPTH, D_MODEL)),
        "peer_w_query": nrm(ks[10], (DEPTH, D_MODEL, PEER_HEADS * PEER_QUERY_DIM), D_MODEL ** -0.5),
        "peer_sub_keys": nrm(ks[11], (DEPTH, PEER_HEADS, 2, N_KEYS, PEER_KEY_DIM), PEER_KEY_DIM ** -0.5),
        "peer_w_down": nrm(ks[12], (DEPTH, N_EXPERTS, D_MODEL), D_MODEL ** -0.5),
        "peer_w_up": nrm(ks[13], (DEPTH, N_EXPERTS, D_MODEL), 0.5),
        "norm_final_g": gain(ks[14], (D_MODEL,)),
    }


def reference(x, norm_mix_g, w_in, q_norm_g, k_norm_g, conv_w, attn_out_g, conv_out_g,
              w_out, norm_ffn_g, peer_w_query, peer_sub_keys, peer_w_down, peer_w_up,
              norm_final_g):
    for layer in range(DEPTH):
        h = rms_norm(x, norm_mix_g[layer])
        x = x + hybrid_mixer(h, w_in[layer], q_norm_g[layer], k_norm_g[layer], conv_w[layer],
                             attn_out_g[layer], conv_out_g[layer], w_out[layer])
        h = rms_norm(x, norm_ffn_g[layer])
        x = x + peer_ffn(h, peer_w_query[layer], peer_sub_keys[layer],
                         peer_w_down[layer], peer_w_up[layer])
    return rms_norm(x, norm_final_g)
```

```cpp
#include <hip/hip_runtime.h>
#include <hip/hip_bf16.h>
#include <cstdio>
#include <cstdint>
namespace pg8 {
#define PG8_LAS __attribute__((address_space(3)))
typedef unsigned short bf16_t;
typedef short bf16x8 __attribute__((ext_vector_type(8)));
typedef float f32x4 __attribute__((ext_vector_type(4)));
typedef unsigned u32x4 __attribute__((ext_vector_type(4)));
constexpr int BM = 256, BK = 64, HALF = 128, HTB = HALF * BK * 2  , STAGE_BYTES = 8 * HTB, NXCD = 8, WGM = 8;

__host__ __device__ __forceinline__ int lds_byte(int r, int c) { const int st = (r >> 4) * 2 + (c >> 5), rr = r & 15, cc = c & 31, ob = rr * 64 + cc * 2; return st * 1024 + (ob ^ (((ob >> 9) & 1) << 5)); }
__host__ __device__ __forceinline__ void stage_rc(int b, int& R, int& C) { const int st = b / 1024, sb = b % 1024, swz = sb ^ (((sb >> 9) & 1) << 5); R = (st >> 1) * 16 + swz / 64; C = (st & 1) * 32 + (swz % 64) / 2; }
__host__ __device__ __forceinline__ int perm32(int rho) { const int n = rho >> 4, i = rho & 15; return 8 * (i >> 2) + 4 * n + (i & 3); }

struct Unit { int pm, pn; };
struct Gemm { const bf16_t* A; const bf16_t* Bt; int M, N, K; };

struct StaticOrder {
    int nM, nN, nwg, G, c;
    __host__ __device__ void init(int M, int N, int G_, int c_) { nM = M / BM; nN = N / BM; nwg = nM * nN; G = G_; c = c_; }
    __host__ __device__ bool next(int i, Unit& u) const {
        const long L = (long)i * G + c; if (L >= nwg) return false;
        int wgid = (int)L; { const int q = nwg / NXCD, r = nwg % NXCD, xcd = wgid % NXCD, off = wgid / NXCD; wgid = (xcd < r ? xcd * (q + 1) : r * (q + 1) + (xcd - r) * q) + off; }
        const int nig = WGM * nN, gid = wgid / nig, fm = gid * WGM, gsz = (nM - fm) < WGM ? (nM - fm) : WGM;
        u.pm = fm + ((wgid % nig) % gsz); u.pn = (wgid % nig) / gsz; return true;
    }
    __device__ __forceinline__ void a_ready(const Unit&) const {}
    __device__ __forceinline__ void done(const Unit&) const {}
};

__device__ __forceinline__ unsigned cvt_pk_bf16(float lo, float hi) { unsigned r; asm volatile("v_cvt_pk_bf16_f32 %0, %1, %2" : "=v"(r) : "v"(lo), "v"(hi)); return r; }
typedef float f32x2 __attribute__((ext_vector_type(2)));
__device__ __forceinline__ f32x2 gelu_pk(f32x2 v) {
    const f32x2 av = __builtin_elementwise_abs(v), d = av * 0.2316418882f + 1.0f;
    f32x2 t; t.x = __builtin_amdgcn_rcpf(d.x); t.y = __builtin_amdgcn_rcpf(d.y);
    f32x2 q = t * 0.5307027145f + (-0.7265760135f); q = q * t + 0.7107068705f; q = q * t + (-0.142248368f); q = q * t + 0.127414796f; q = q * t;
    const f32x2 s = (v * v) * (-0.72134752044f);
    f32x2 e; e.x = __builtin_amdgcn_exp2f(s.x); e.y = __builtin_amdgcn_exp2f(s.y);
    const f32x2 m = v * (q * e), r = v - m;
    f32x2 o; o.x = v.x < 0.f ? m.x : r.x; o.y = v.y < 0.f ? m.y : r.y; return o;
}

template <int ACT  > struct EpiBf16 {
    static constexpr bool PERM = true, AFTER_DRAIN = false; static_assert(ACT == 0 || ACT == 1, "EpiBf16: ACT is 0 (none) or 1 (gelu_pk)");
    bf16_t* O; int ldc; const float* bias; int split_cols; size_t split_stride; float scale0;
    __device__ __forceinline__ void operator()(const f32x4 (&acc)[2][2][4][2], const Unit& u, int wr, int wc, int fr, int fq) const {
        const int row0 = u.pm * BM + wr * 64 + fr; int colt = u.pn * BM; bf16_t* base = O;
        float sc = 1.f; if (split_cols) { const int t = colt / split_cols; base += (size_t)t * split_stride; colt -= t * split_cols; if (t == 0) sc = scale0; }
        const int col0 = colt + wc * 32 + 8 * fq, bcol0 = u.pn * BM + wc * 32 + 8 * fq;
        f32x4 bv[2][2];
#pragma unroll
        for (int bj = 0; bj < 2; ++bj)
#pragma unroll
            for (int n = 0; n < 2; ++n) bv[bj][n] = bias ? *(const f32x4*)(bias + bcol0 + bj * HALF + 4 * n) : (f32x4){0.f, 0.f, 0.f, 0.f};
#pragma unroll
        for (int ai = 0; ai < 2; ++ai)
#pragma unroll
            for (int m = 0; m < 4; ++m) { bf16_t* rowp = base + (size_t)(row0 + ai * HALF + m * 16) * ldc + col0;
#pragma unroll
                for (int bj = 0; bj < 2; ++bj) { f32x4 v0 = acc[ai][bj][m][0] + bv[bj][0], v1 = acc[ai][bj][m][1] + bv[bj][1];
                    if (ACT == 1) { f32x2 a = gelu_pk((f32x2){v0[0], v0[1]}), b = gelu_pk((f32x2){v0[2], v0[3]}), c = gelu_pk((f32x2){v1[0], v1[1]}), d = gelu_pk((f32x2){v1[2], v1[3]});
                        v0 = (f32x4){a.x, a.y, b.x, b.y}; v1 = (f32x4){c.x, c.y, d.x, d.y}; }
                    v0 = v0 * sc; v1 = v1 * sc; u32x4 w; w.x = cvt_pk_bf16(v0[0], v0[1]); w.y = cvt_pk_bf16(v0[2], v0[3]); w.z = cvt_pk_bf16(v1[0], v1[1]); w.w = cvt_pk_bf16(v1[2], v1[3]);
                    *(u32x4*)(rowp + bj * HALF) = w; } }
    }
};
struct EpiResF32 {
    static constexpr bool PERM = false, AFTER_DRAIN = false;
    const float* base; float* out; int ldc;
    __device__ __forceinline__ void operator()(const f32x4 (&acc)[2][2][4][2], const Unit& u, int wr, int wc, int fr, int fq) const {
        const int row0 = u.pm * BM + wr * 64 + fr, col0 = u.pn * BM + wc * 32 + 4 * fq;
#pragma unroll
        for (int ai = 0; ai < 2; ++ai)
#pragma unroll
            for (int m = 0; m < 4; ++m) { const size_t off = (size_t)(row0 + ai * HALF + m * 16) * ldc + col0;
                f32x4 b[2][2];
#pragma unroll
                for (int bj = 0; bj < 2; ++bj)
#pragma unroll
                    for (int n = 0; n < 2; ++n) b[bj][n] = *(const f32x4*)(base + off + bj * HALF + n * 16);
#pragma unroll
                for (int bj = 0; bj < 2; ++bj)
#pragma unroll
                    for (int n = 0; n < 2; ++n) *(f32x4*)(out + off + bj * HALF + n * 16) = b[bj][n] + acc[ai][bj][m][n];
                if (m & 1) asm volatile("" ::: "memory"); }
    }
};
struct EpiF32Plain {
    static constexpr bool PERM = false, AFTER_DRAIN = false;
    float* C; int ldc;
    __device__ __forceinline__ void operator()(const f32x4 (&acc)[2][2][4][2], const Unit& u, int wr, int wc, int fr, int fq) const {
        const int row0 = u.pm * BM + wr * 64 + fr, col0 = u.pn * BM + wc * 32 + 4 * fq;
#pragma unroll
        for (int ai = 0; ai < 2; ++ai)
#pragma unroll
            for (int m = 0; m < 4; ++m) { float* rowp = C + (size_t)(row0 + ai * HALF + m * 16) * ldc + col0;
#pragma unroll
                for (int bj = 0; bj < 2; ++bj)
#pragma unroll
                    for (int n = 0; n < 2; ++n) *(f32x4*)(rowp + bj * HALF + n * 16) = acc[ai][bj][m][n]; }
    }
};
struct EpiGeluGate {
    static constexpr bool PERM = true, AFTER_DRAIN = false;
    bf16_t* G; int ldc;
    __device__ __forceinline__ void operator()(const f32x4 (&acc)[2][2][4][2], const Unit& u, int wr, int wc, int fr, int fq) const {
        const int row0 = u.pm * BM + wr * 64 + fr, col0 = u.pn * BM + wc * 32 + 8 * fq;
#pragma unroll
        for (int ai = 0; ai < 2; ++ai) {
            u32x4 g[4][2];
#pragma unroll
            for (int m = 0; m < 4; ++m)
#pragma unroll
                for (int bj = 0; bj < 2; ++bj) g[m][bj] = *(const u32x4*)(G + (size_t)(row0 + ai * HALF + m * 16) * ldc + col0 + bj * HALF);
#pragma unroll
            for (int m = 0; m < 4; ++m)
#pragma unroll
                for (int bj = 0; bj < 2; ++bj) { const u32x4 gw = g[m][bj];
                    if ((gw.x | gw.y | gw.z | gw.w) != 0u) {
                        const f32x4 v0 = acc[ai][bj][m][0], v1 = acc[ai][bj][m][1];
                        const f32x2 a = gelu_pk((f32x2){v0[0], v0[1]}), b = gelu_pk((f32x2){v0[2], v0[3]}), c = gelu_pk((f32x2){v1[0], v1[1]}), d = gelu_pk((f32x2){v1[2], v1[3]});
                        u32x4 w;
                        w.x = cvt_pk_bf16(a.x * __uint_as_float(gw.x << 16), a.y * __uint_as_float(gw.x & 0xffff0000u));
                        w.y = cvt_pk_bf16(b.x * __uint_as_float(gw.y << 16), b.y * __uint_as_float(gw.y & 0xffff0000u));
                        w.z = cvt_pk_bf16(c.x * __uint_as_float(gw.z << 16), c.y * __uint_as_float(gw.z & 0xffff0000u));
                        w.w = cvt_pk_bf16(d.x * __uint_as_float(gw.w << 16), d.y * __uint_as_float(gw.w & 0xffff0000u));
                        *(u32x4*)(G + (size_t)(row0 + ai * HALF + m * 16) * ldc + col0 + bj * HALF) = w; } }
        }
    }
};
template <class Epi, class Sched, bool ALIGN_EPI = false, bool SP2 = false>
__device__ __forceinline__ void gemm_phase(PG8_LAS unsigned char* lds, const Gemm g, const Sched& S, const Epi& E, const int wave_id  ) {
    int tid_ = (wave_id << 6) | (int)__builtin_amdgcn_mbcnt_hi(~0u, __builtin_amdgcn_mbcnt_lo(~0u, 0u)); asm volatile("" : "+v"(tid_));
    const int tid = tid_, wid = __builtin_amdgcn_readfirstlane(tid >> 6), lane = tid & 63, wr = wid >> 2, wc = wid & 3, fr = lane & 15, fq = lane >> 4;
    const int K = g.K, nt = K / BK;
    unsigned voffA[2], voffB[2];
#pragma unroll
    for (int i = 0; i < 2; ++i) { int R, C; stage_rc(tid * 16 + i * 8192, R, C); const int Rb = Epi::PERM ? ((R & ~31) + perm32(R & 31)) : R;
        voffA[i] = (unsigned)(R * K + C) * 2u; voffB[i] = (unsigned)(Rb * K + C) * 2u; }
    const size_t kstep = (size_t)(BK * 2);
    const size_t hstep = (size_t)HALF * K * 2;
    const size_t tstep = 2 * hstep;
    const unsigned ldsw = (unsigned)wid * 1024u;
    const int aoff = lds_byte(wr * 64 + fr, fq * 8), boff = lds_byte(wc * 32 + fr, fq * 8);
#define PG8_SA(b, h) (((b) * 2 + (h)) * HTB)
#define PG8_SB(b, h) ((4 + (b) * 2 + (h)) * HTB)
#define PG8_STAGE(bufoff, gbase, voff) do { _Pragma("unroll") for (int _i = 0; _i < 2; ++_i) \
        __builtin_amdgcn_global_load_lds((const unsigned*)((const char*)(gbase) + (voff)[_i]), (PG8_LAS unsigned*)(lds + (bufoff) + ldsw + _i * 8192), 16, 0, 0); } while (0)
#define PG8_LDA(dst, b, h) do { _Pragma("unroll") for (int m = 0; m < 4; ++m) _Pragma("unroll") for (int k = 0; k < 2; ++k) dst[m][k] = *(const PG8_LAS bf16x8*)(lds + PG8_SA(b, h) + aoff + m * 2048 + k * 1024); } while (0)
#define PG8_LDB(dst, b, h) do { _Pragma("unroll") for (int n = 0; n < 2; ++n) _Pragma("unroll") for (int k = 0; k < 2; ++k) dst[n][k] = *(const PG8_LAS bf16x8*)(lds + PG8_SB(b, h) + boff + n * 2048 + k * 1024); } while (0)
#define PG8_MMA(ai, bj, At, Bt) do { __builtin_amdgcn_s_setprio(1); _Pragma("unroll") for (int m = 0; m < 4; ++m) _Pragma("unroll") for (int n = 0; n < 2; ++n) _Pragma("unroll") for (int k = 0; k < 2; ++k) \
        acc[ai][bj][m][n] = __builtin_amdgcn_mfma_f32_16x16x32_bf16(Bt[n][k], At[m][k], acc[ai][bj][m][n], 0, 0, 0); __builtin_amdgcn_s_setprio(0); } while (0)
#define PG8_WAIT_V(n) asm volatile("s_waitcnt vmcnt(" #n ")" ::: "memory")
#define PG8_WAIT_L(n) asm volatile("s_waitcnt lgkmcnt(" #n ")" ::: "memory")
#define PG8_BAR __builtin_amdgcn_s_barrier()
#define PG8_SCHED __builtin_amdgcn_sched_barrier(0)
    Unit cur, nxt; int ui = 0;
    if (!S.next(0, cur)) return;
    f32x4 acc[2][2][4][2];
#pragma unroll
    for (int a = 0; a < 2; ++a)
#pragma unroll
        for (int b = 0; b < 2; ++b)
#pragma unroll
            for (int m = 0; m < 4; ++m)
#pragma unroll
                for (int n = 0; n < 2; ++n) acc[a][b][m][n] = (f32x4){0.f, 0.f, 0.f, 0.f};
    bf16x8 At[4][2], B0[2][2], B1[2][2];
    const char* cA = (const char*)g.A + (size_t)cur.pm * tstep; const char* cB = (const char*)g.Bt + (size_t)cur.pn * tstep;
    S.a_ready(cur);
    if constexpr (SP2) {
        PG8_STAGE(PG8_SB(0, 0), cB, voffB); PG8_STAGE(PG8_SB(0, 1), cB + hstep, voffB); PG8_STAGE(PG8_SA(0, 0), cA, voffA); PG8_STAGE(PG8_SA(0, 1), cA + hstep, voffA);
        if (wr == 1) PG8_BAR;
        PG8_WAIT_V(2); PG8_BAR;
        PG8_STAGE(PG8_SB(1, 0), cB + kstep, voffB); PG8_STAGE(PG8_SA(1, 0), cA + kstep, voffA); PG8_STAGE(PG8_SB(1, 1), cB + hstep + kstep, voffB);
        PG8_WAIT_V(6); PG8_BAR;
    } else {
        PG8_STAGE(PG8_SB(0, 0), cB, voffB); PG8_STAGE(PG8_SA(0, 0), cA, voffA); PG8_STAGE(PG8_SB(0, 1), cB + hstep, voffB); PG8_STAGE(PG8_SA(0, 1), cA + hstep, voffA);
        if (wr == 1) PG8_BAR;
        PG8_WAIT_V(4); PG8_BAR;
        PG8_STAGE(PG8_SB(1, 0), cB + kstep, voffB); PG8_STAGE(PG8_SA(1, 0), cA + kstep, voffA); PG8_STAGE(PG8_SB(1, 1), cB + hstep + kstep, voffB);
        PG8_WAIT_V(6); PG8_BAR;
    }
    for (;;) {
        const bool has_next = S.next(ui + 1, nxt);
        const char* nA = has_next ? (const char*)g.A + (size_t)nxt.pm * tstep : cA; const char* nB = has_next ? (const char*)g.Bt + (size_t)nxt.pn * tstep : cB;
        for (int t = 0; t < nt; t += 2) {
            const bool last = (t == nt - 2);
            const char* a1 = cA + (size_t)(t + 1) * kstep;
            const char* a2 = last ? nA : cA + (size_t)(t + 2) * kstep; const char* b2 = last ? nB : cB + (size_t)(t + 2) * kstep;
            const char* a3 = a2 + kstep; const char* b3 = b2 + kstep;
            if (last && has_next) S.a_ready(nxt);
            if constexpr (SP2) {
            PG8_LDB(B0, 0, 0); PG8_LDB(B1, 0, 1); PG8_SCHED; PG8_LDA(At, 0, 0); PG8_STAGE(PG8_SA(1, 1), a1 + hstep, voffA);
            PG8_WAIT_V(8); PG8_WAIT_L(0); PG8_BAR; PG8_MMA(0, 0, At, B0); PG8_MMA(0, 1, At, B1); PG8_BAR; PG8_SCHED;
            PG8_LDA(At, 0, 1); PG8_STAGE(PG8_SB(0, 0), b2, voffB); PG8_STAGE(PG8_SB(0, 1), b2 + hstep, voffB); PG8_STAGE(PG8_SA(0, 0), a2, voffA);
            PG8_WAIT_V(8); PG8_WAIT_L(0); PG8_BAR; PG8_MMA(1, 0, At, B0); PG8_MMA(1, 1, At, B1); PG8_BAR; PG8_SCHED;
            PG8_LDB(B0, 1, 0); PG8_LDB(B1, 1, 1); PG8_SCHED; PG8_LDA(At, 1, 0); PG8_STAGE(PG8_SA(0, 1), a2 + hstep, voffA);
            PG8_WAIT_V(8); PG8_WAIT_L(0); PG8_BAR; PG8_MMA(0, 0, At, B0); PG8_MMA(0, 1, At, B1); PG8_BAR; PG8_SCHED;
            PG8_LDA(At, 1, 1); PG8_STAGE(PG8_SB(1, 0), b3, voffB); PG8_STAGE(PG8_SB(1, 1), b3 + hstep, voffB); PG8_STAGE(PG8_SA(1, 0), a3, voffA);
            PG8_WAIT_V(8); PG8_WAIT_L(0); PG8_BAR; PG8_MMA(1, 0, At, B0); PG8_MMA(1, 1, At, B1); PG8_BAR; PG8_SCHED;
            } else {
            PG8_LDB(B0, 0, 0); PG8_SCHED; PG8_LDA(At, 0, 0); PG8_STAGE(PG8_SA(1, 1), a1 + hstep, voffA);
            PG8_WAIT_L(8); PG8_BAR; PG8_WAIT_L(0); PG8_MMA(0, 0, At, B0); PG8_BAR; PG8_SCHED;
            PG8_LDB(B1, 0, 1); PG8_STAGE(PG8_SB(0, 0), b2, voffB);
            PG8_BAR; PG8_WAIT_L(0); PG8_MMA(0, 1, At, B1); PG8_BAR;
            PG8_LDA(At, 0, 1); PG8_STAGE(PG8_SA(0, 0), a2, voffA);
            PG8_BAR; PG8_WAIT_L(0); PG8_MMA(1, 0, At, B0); PG8_BAR; PG8_SCHED;
            PG8_STAGE(PG8_SB(0, 1), b2 + hstep, voffB);
            PG8_WAIT_V(6); PG8_BAR; PG8_MMA(1, 1, At, B1); PG8_BAR;
            PG8_LDB(B0, 1, 0); PG8_SCHED; PG8_LDA(At, 1, 0); PG8_STAGE(PG8_SA(0, 1), a2 + hstep, voffA);
            PG8_WAIT_L(8); PG8_BAR; PG8_WAIT_L(0); PG8_MMA(0, 0, At, B0); PG8_BAR; PG8_SCHED;
            PG8_LDB(B1, 1, 1); PG8_STAGE(PG8_SB(1, 0), b3, voffB);
            PG8_BAR; PG8_WAIT_L(0); PG8_MMA(0, 1, At, B1); PG8_BAR;
            PG8_LDA(At, 1, 1); PG8_STAGE(PG8_SA(1, 0), a3, voffA);
            PG8_BAR; PG8_WAIT_L(0); PG8_MMA(1, 0, At, B0); PG8_BAR; PG8_SCHED;
            PG8_STAGE(PG8_SB(1, 1), b3 + hstep, voffB);
            PG8_WAIT_V(6); PG8_BAR; PG8_MMA(1, 1, At, B1); PG8_BAR;
            }
        }
        if constexpr (ALIGN_EPI) { if (wr == 0) PG8_BAR; }
        if constexpr (!Epi::AFTER_DRAIN) { E(acc, cur, wr, wc, fr, fq); S.done(cur); }
        if (!has_next) break;
#pragma unroll
        for (int a = 0; a < 2; ++a)
#pragma unroll
            for (int b = 0; b < 2; ++b)
#pragma unroll
                for (int m = 0; m < 4; ++m)
#pragma unroll
                    for (int n = 0; n < 2; ++n) acc[a][b][m][n] = (f32x4){0.f, 0.f, 0.f, 0.f};
        cur = nxt; cA = nA; cB = nB; ++ui;
        if constexpr (ALIGN_EPI) { if (wr == 1) PG8_BAR; }
    }
    PG8_WAIT_V(0);
    if constexpr (!ALIGN_EPI) { if (wr == 0) PG8_BAR; }
    PG8_BAR;
    if constexpr (Epi::AFTER_DRAIN) { E.fused(acc, cur, wr, wc, fr, fq, lds, wid, lane); S.done(cur); }
#undef PG8_SA
#undef PG8_SB
#undef PG8_STAGE
#undef PG8_LDA
#undef PG8_LDB
#undef PG8_MMA
#undef PG8_WAIT_V
#undef PG8_WAIT_L
#undef PG8_BAR
#undef PG8_SCHED
}
}
namespace attn128 {
using bf16 = __hip_bfloat16;
constexpr int   D = 128, NW = 8, QBLK = 32, KVBLK = 64;
constexpr float SCALE = 0.088388347648318440f;
constexpr float THR = 8.f;
constexpr int SDEPTH = 2;
constexpr int LDQ = 9216, LDK = 9216, LDO = 4096;
constexpr size_t SHM_V = KVBLK * D * 2, SHM_K = KVBLK * D * 2, SHM_ATTN = 2 * SHM_V + 2 * SHM_K + NW * 64 * 4;
using bf16x8 = __attribute__((ext_vector_type(8))) short;
using s16x4  = __attribute__((ext_vector_type(4))) short;
using f32x16 = __attribute__((ext_vector_type(16))) float;
using f32x8  = __attribute__((ext_vector_type(8))) float;
using u32x4  = __attribute__((ext_vector_type(4))) unsigned;
#define KSWZ(row, colB) ((row) * 256 + ((colB) ^ (((row) & 7) << 4)))
#define SBAR() __builtin_amdgcn_sched_barrier(0)
__device__ __forceinline__ int crow(int r, int hi) { return (r & 3) + 8 * (r >> 2) + 4 * hi; }
__device__ __forceinline__ unsigned cvtpk(float lo, float hi) {
  unsigned r; asm volatile("v_cvt_pk_bf16_f32 %0, %1, %2" : "=v"(r) : "v"(lo), "v"(hi)); return r;
}
template <typename TIn> struct Stage;
template <> struct Stage<bf16>  { using T = bf16x8;
  __device__ static __forceinline__ T ld8(const bf16* p) { return *reinterpret_cast<const bf16x8*>(p); }
  __device__ static __forceinline__ bf16x8 tobf(T x) { return x; } };
template <> struct Stage<float> { using T = f32x8;
  __device__ static __forceinline__ T ld8(const float* p) { return *reinterpret_cast<const f32x8*>(p); }
  __device__ static __forceinline__ bf16x8 tobf(T x) {
    u32x4 w = {cvtpk(x[0], x[1]), cvtpk(x[2], x[3]), cvtpk(x[4], x[5]), cvtpk(x[6], x[7])}; return *reinterpret_cast<bf16x8*>(&w); } };

__device__ __forceinline__ void partialSM(f32x16& p0, f32x16& p1, float& m_reg, float& mn, float& alpha) {
  constexpr float C = SCALE * 1.4426950408889634f;
  float pmax = p0[0]; for (int r = 1; r < 16; ++r) pmax = fmaxf(pmax, p0[r]); for (int r = 0; r < 16; ++r) pmax = fmaxf(pmax, p1[r]);
  { auto rr = __builtin_amdgcn_permlane32_swap(__float_as_uint(pmax), __float_as_uint(pmax), false, false);
    pmax = fmaxf(__uint_as_float(rr[0]), __uint_as_float(rr[1])); }
  if (__builtin_expect(__all(pmax - m_reg <= THR / SCALE), 1)) { mn = m_reg; alpha = 1.f; }
  else { mn = fmaxf(m_reg, pmax); alpha = __builtin_amdgcn_exp2f((m_reg - mn) * C); m_reg = mn; }
  float mnC = -mn * C;
  for (int r = 0; r < 16; ++r) p0[r] = fmaf(p0[r], C, mnC); for (int r = 0; r < 16; ++r) p1[r] = fmaf(p1[r], C, mnC);
  for (int r = 0; r < 16; ++r) p0[r] = __builtin_amdgcn_exp2f(p0[r]);
}
__device__ __forceinline__ void finishSM(f32x16& p0, f32x16& p1, float alpha, float& l_reg, bf16x8& pa0, bf16x8& pa1, bf16x8& pa2, bf16x8& pa3) {
  for (int r = 0; r < 16; ++r) p1[r] = __builtin_amdgcn_exp2f(p1[r]);
  float ps = 0; for (int r = 0; r < 16; ++r) ps += p0[r]; for (int r = 0; r < 16; ++r) ps += p1[r];
  { auto rr = __builtin_amdgcn_permlane32_swap(__float_as_uint(ps), __float_as_uint(ps), false, false);
    ps = __uint_as_float(rr[0]) + __uint_as_float(rr[1]); }
  l_reg = l_reg * alpha + ps;
#define PK4(P, BASE, OUT) do { unsigned a0 = cvtpk(P[BASE + 0], P[BASE + 1]), a1 = cvtpk(P[BASE + 2], P[BASE + 3]);   \
    unsigned b0 = cvtpk(P[BASE + 4], P[BASE + 5]), b1 = cvtpk(P[BASE + 6], P[BASE + 7]);                              \
    auto r0 = __builtin_amdgcn_permlane32_swap(a0, b0, false, false); auto r1 = __builtin_amdgcn_permlane32_swap(a1, b1, false, false); \
    u32x4 w = {r0[0], r1[0], r0[1], r1[1]}; OUT = *reinterpret_cast<bf16x8*>(&w); } while (0)
  PK4(p0, 0, pa0); PK4(p0, 8, pa1); PK4(p1, 0, pa2); PK4(p1, 8, pa3);
#undef PK4
}
__device__ __forceinline__ void qkt(f32x16& p0, f32x16& p1, const bf16* Ks, const bf16x8* qr, int r32, int hi) {
  p0 = f32x16{}; p1 = f32x16{};
  for (int d0 = 0; d0 < 8; ++d0) { int cb = (d0 * 16 + hi * 8) * 2;
    bf16x8 b0 = *reinterpret_cast<const bf16x8*>((const char*)Ks + KSWZ(r32, cb));
    bf16x8 b1 = *reinterpret_cast<const bf16x8*>((const char*)Ks + KSWZ(32 + r32, cb));
    p0 = __builtin_amdgcn_mfma_f32_32x32x16_bf16(b0, qr[d0], p0, 0, 0, 0);
    p1 = __builtin_amdgcn_mfma_f32_32x32x16_bf16(b1, qr[d0], p1, 0, 0, 0); }
}
__device__ __forceinline__ int v_st(int k, int c) { const int kk = (k & ~0xC) | ((k & 4) << 1) | ((k & 8) >> 1); return ((kk >> 3) * 4 + (c >> 5)) * 512 + ((kk & 7) * 32 + (c & 31)) * 2; }
__device__ __forceinline__ int v_rd_base(int lane) { return ((lane & 3) << 3) | (((lane >> 2) & 3) << 6) | (((lane >> 4) & 1) << 5) | (((lane >> 5) & 1) << 8); }
constexpr int v_rd_off(int d0, int ks, int half) { return d0 * 512 + ks * 4096 + half * 2048; }
template <int OFF> __device__ __forceinline__ s16x4 tr_read(int vb) {
  s16x4 r; asm volatile("ds_read_b64_tr_b16 %0, %1 offset:%2" : "=&v"(r) : "v"(vb), "i"(OFF) : "memory"); return r;
}
template <int D0> __device__ __forceinline__ void pv_one(f32x16& od, int vb, bf16x8 pa0, bf16x8 pa1, bf16x8 pa2, bf16x8 pa3) {
  const s16x4 l0 = tr_read<v_rd_off(D0, 0, 0)>(vb), h0 = tr_read<v_rd_off(D0, 0, 1)>(vb), l1 = tr_read<v_rd_off(D0, 1, 0)>(vb), h1 = tr_read<v_rd_off(D0, 1, 1)>(vb);
  const s16x4 l2 = tr_read<v_rd_off(D0, 2, 0)>(vb), h2 = tr_read<v_rd_off(D0, 2, 1)>(vb), l3 = tr_read<v_rd_off(D0, 3, 0)>(vb), h3 = tr_read<v_rd_off(D0, 3, 1)>(vb);
  asm volatile("s_waitcnt lgkmcnt(0)" ::: "memory"); SBAR();
#define PK(L, H) (bf16x8){L[0], L[1], L[2], L[3], H[0], H[1], H[2], H[3]}
  od = __builtin_amdgcn_mfma_f32_32x32x16_bf16(pa0, PK(l0, h0), od, 0, 0, 0);
  od = __builtin_amdgcn_mfma_f32_32x32x16_bf16(pa1, PK(l1, h1), od, 0, 0, 0);
  od = __builtin_amdgcn_mfma_f32_32x32x16_bf16(pa2, PK(l2, h2), od, 0, 0, 0);
  od = __builtin_amdgcn_mfma_f32_32x32x16_bf16(pa3, PK(l3, h3), od, 0, 0, 0);
#undef PK
}
__device__ __forceinline__ void pv_d0(f32x16* o, int vb, bf16x8 pa0, bf16x8 pa1, bf16x8 pa2, bf16x8 pa3) {
  pv_one<0>(o[0], vb, pa0, pa1, pa2, pa3); pv_one<1>(o[1], vb, pa0, pa1, pa2, pa3); pv_one<2>(o[2], vb, pa0, pa1, pa2, pa3); pv_one<3>(o[3], vb, pa0, pa1, pa2, pa3);
}

template <typename TQ>
__device__ __forceinline__ void attn_dense_body(const TQ* __restrict__ Qb, const bf16* __restrict__ Kh, const bf16* __restrict__ Vh,
                                                bf16* __restrict__ Ob, int seq, char* lds, const int wave_id) {
  using St = Stage<bf16>; using SQ = Stage<TQ>;
  int tid_ = (wave_id << 6) | (int)__builtin_amdgcn_mbcnt_hi(~0u, __builtin_amdgcn_mbcnt_lo(~0u, 0u)); asm volatile("" : "+v"(tid_));
  const int tid = tid_, wid = tid >> 6, lane = tid & 63, r32 = lane & 31, hi = lane >> 5;
  bf16* V_lds = (bf16*)lds; bf16* K_lds = (bf16*)(lds + 2 * SHM_V);
  float* ws = (float*)(lds + 2 * SHM_V + 2 * SHM_K) + wid * 64; float* li_l = ws; float* al_l = ws + 32;
  float m_reg = -1e30f, l_reg = 0; f32x16 o[4] = {}; bf16x8 qr[8];
  const TQ* Qw = Qb + (long)(wid * QBLK + r32) * LDQ + hi * 8;
#pragma unroll
  for (int d0 = 0; d0 < 8; ++d0) qr[d0] = SQ::tobf(SQ::ld8(Qw + d0 * 16));
  const int sr = tid >> 4, sc = (tid & 15) * 8, vst0 = v_st(sr, sc), vst1 = v_st(32 + sr, sc);
  const int vb0 = (int)(uintptr_t)V_lds + v_rd_base(lane);
  struct { typename St::T vs0, vs1, ks0, ks1; } sr_[SDEPTH];
#define SLOAD(i, k0) do { sr_[i].vs0 = St::ld8(&Vh[(long)((k0) + sr) * LDK + sc]); sr_[i].vs1 = St::ld8(&Vh[(long)((k0) + 32 + sr) * LDK + sc]); \
    sr_[i].ks0 = St::ld8(&Kh[(long)((k0) + sr) * LDK + sc]); sr_[i].ks1 = St::ld8(&Kh[(long)((k0) + 32 + sr) * LDK + sc]); } while (0)
#define SWRITE(b, i) do { *(bf16x8*)((char*)V_lds + (b) * SHM_V + vst0) = St::tobf(sr_[i].vs0);          \
    *(bf16x8*)((char*)V_lds + (b) * SHM_V + vst1) = St::tobf(sr_[i].vs1); int kc = sc * 2;               \
    *(bf16x8*)((char*)K_lds + (b) * SHM_K + KSWZ(sr, kc)) = St::tobf(sr_[i].ks0);                       \
    *(bf16x8*)((char*)K_lds + (b) * SHM_K + KSWZ(32 + sr, kc)) = St::tobf(sr_[i].ks1); } while (0)
#define SWAIT() do { if constexpr (SDEPTH == 2) asm volatile("s_waitcnt vmcnt(4)" ::: "memory"); else asm volatile("s_waitcnt vmcnt(0)" ::: "memory"); } while (0)
#define RESC(a) do { if (__any((a) < 1.f)) { if (hi == 0) al_l[r32] = (a); asm volatile("s_waitcnt lgkmcnt(0)" ::: "memory"); \
    for (int d = 0; d < 4; ++d) for (int r = 0; r < 16; ++r) o[d][r] *= al_l[crow(r, hi)]; } } while (0)
  f32x16 pA0, pA1, pB0, pB1; float mnA, mnB, alA, alB; bf16x8 pa0, pa1, pa2, pa3; const int NT = seq / KVBLK;
  constexpr int SE = 0, SO = SDEPTH - 1;
  SLOAD(SE, 0); asm volatile("s_waitcnt vmcnt(0)" ::: "memory"); SWRITE(0, SE); __syncthreads();
  qkt(pA0, pA1, K_lds, qr, r32, hi); partialSM(pA0, pA1, m_reg, mnA, alA);
  SLOAD(SO, KVBLK); if constexpr (SDEPTH == 2) { if (2 < NT) SLOAD(SE, 2 * KVBLK); }
  SWAIT(); SWRITE(1, SO); __syncthreads();
  for (int j = 1; j + 1 < NT; j += 2) {
    SBAR(); qkt(pB0, pB1, (bf16*)((char*)K_lds + SHM_K), qr, r32, hi);
    finishSM(pA0, pA1, alA, l_reg, pa0, pa1, pa2, pa3); SBAR();
    SLOAD(SO, (j + SDEPTH) * KVBLK); SBAR();
    pv_d0(o, vb0, pa0, pa1, pa2, pa3); partialSM(pB0, pB1, m_reg, mnB, alB);
    __syncthreads(); SWAIT(); SWRITE(0, SE);
    RESC(alB); __syncthreads();
    SBAR(); qkt(pA0, pA1, K_lds, qr, r32, hi);
    finishSM(pB0, pB1, alB, l_reg, pa0, pa1, pa2, pa3); SBAR();
    if (SDEPTH == 1 || j + 3 < NT) SLOAD(SE, (j + 1 + SDEPTH) * KVBLK); SBAR();
    pv_d0(o, vb0 + (int)SHM_V, pa0, pa1, pa2, pa3); partialSM(pA0, pA1, m_reg, mnA, alA);
    __syncthreads(); SWAIT(); SWRITE(1, SO);
    RESC(alA); __syncthreads();
  }
  SBAR(); qkt(pB0, pB1, (bf16*)((char*)K_lds + SHM_K), qr, r32, hi);
  finishSM(pA0, pA1, alA, l_reg, pa0, pa1, pa2, pa3); SBAR();
  pv_d0(o, vb0, pa0, pa1, pa2, pa3); partialSM(pB0, pB1, m_reg, mnB, alB);
  __syncthreads(); RESC(alB);
  finishSM(pB0, pB1, alB, l_reg, pa0, pa1, pa2, pa3); SBAR();
  pv_d0(o, vb0 + (int)SHM_V, pa0, pa1, pa2, pa3);
  if (hi == 0) li_l[r32] = l_reg; asm volatile("s_waitcnt lgkmcnt(0)" ::: "memory");
  float rli[16];
#pragma unroll
  for (int r = 0; r < 16; ++r) rli[r] = __builtin_amdgcn_rcpf(li_l[crow(r, hi)]);
  bf16* Ow = Ob + (long)(wid * QBLK) * LDO;
#pragma unroll
  for (int r = 0; r < 16; ++r) { int orow = crow(r, hi);
    for (int d0 = 0; d0 < 4; ++d0) Ow[(long)orow * LDO + d0 * 32 + r32] = __float2bfloat16(o[d0][r] * rli[r]); }
#undef SLOAD
#undef SWRITE
#undef SWAIT
#undef RESC
}

#undef KSWZ
#undef SBAR
}
constexpr int NWAVES = 8;
constexpr int BATCH = 2, SEQ = 8192, DM = 4096, M = BATCH * SEQ;
constexpr int HD = 128, ATTN_W = 2048, CONV_W = 2048, NQH = 16, NKVH = 4, KV_W = 512;
constexpr int IN_COLS = 9216;
constexpr int C_Q = 0, C_K = 2048, C_V = 2560, C_CX = 3072, C_GB = 5120, C_GC = 7168;
constexpr int GRID_W = 64;
constexpr int NKEYS = 128, NEXP = 16384, PHEADS = 8, PTOPK = 16, PQ = 2048;
constexpr float EPS = 1e-6f;

constexpr size_t MiB = 1u << 20;
constexpr size_t WS_CTL = 0, CTL_ZERO_BYTES = 1 * MiB;
constexpr size_t WS_WD   = 1 * MiB;
constexpr size_t WS_H    = 129 * MiB;
constexpr size_t WS_G    = 257 * MiB;
constexpr size_t WS_PROJ = 257 * MiB;
constexpr size_t WS_Y    = 545 * MiB;
constexpr size_t WS_WIN  = 673 * MiB;
constexpr size_t WS_WSC  = 745 * MiB;
constexpr size_t WS_SC   = 769 * MiB;
constexpr size_t WS_WUP  = 769 * MiB;
constexpr size_t WS_WOUT = 897 * MiB;
constexpr size_t WS_END  = 929 * MiB;
static_assert(WS_WSC + 16 * MiB <= WS_G + 512 * MiB && WS_G + 512 * MiB <= WS_SC, "d_ws map");
constexpr int CW_TMO = 0, CW_CODE = 1, CW_BAR = 4096;

constexpr int RING_OFF = 0, RING_BYTES = 131072;
constexpr int LDSCTL_OFF = RING_BYTES, MISC_OFF = LDSCTL_OFF + 320;
constexpr int TK_OFF = LDSCTL_OFF + 512;
constexpr int LDS_BYTES = 147456;
static_assert(TK_OFF + NWAVES * 512 <= LDS_BYTES, "LDS map");

#define GAS __attribute__((address_space(1)))
#define LAS __attribute__((address_space(3)))
typedef unsigned short bf16;
typedef unsigned v4u __attribute__((ext_vector_type(4)));
typedef float f32x4 __attribute__((ext_vector_type(4)));
typedef short bf16x8 __attribute__((ext_vector_type(8)));
typedef GAS unsigned gu32;
typedef GAS unsigned long long gu64;
#define RLX_AGENT __ATOMIC_RELAXED, __HIP_MEMORY_SCOPE_AGENT
#define LDS_WAIT() asm volatile("s_waitcnt lgkmcnt(0)" ::: "memory")
#define VM_WAIT() asm volatile("s_waitcnt vmcnt(0)" ::: "memory")
__device__ __forceinline__ unsigned long long rt() { return __builtin_amdgcn_s_memrealtime(); }
__device__ __forceinline__ unsigned f2bf(float f) { unsigned u = __builtin_bit_cast(unsigned, f); return (u + 0x7fffu + ((u >> 16) & 1u)) >> 16; }
__device__ __forceinline__ unsigned pk2(float lo, float hi) { return f2bf(lo) | (f2bf(hi) << 16); }

#define XB_TMO      128
#define XB_XCNT(j)  (256  + 64 * (j))
#define XB_XSUB(j)  (1280 + 64 * (j))
#define XB_XGEN(j)  (2304 + 64 * (j))
#define XB_TOP      3328
#define XB_TOPGEN   3392
#define XCD_BAR_WORDS 3456
#define XB_SPIN_CAP (1u << 18)

__device__ __forceinline__ unsigned xb_ld(unsigned* p)              { return __hip_atomic_load(p, __ATOMIC_RELAXED, __HIP_MEMORY_SCOPE_AGENT); }
__device__ __forceinline__ unsigned xb_add(unsigned* p, unsigned v) { return __hip_atomic_fetch_add(p, v, __ATOMIC_RELAXED, __HIP_MEMORY_SCOPE_AGENT); }
__device__ __forceinline__ unsigned xb_xcc_id() { return (unsigned)__builtin_amdgcn_s_getreg((3 << 11) | 20) & 0xFu; }
#define XB_SPIN(cond, bar) do { unsigned _sp = 0; while (cond) { __builtin_amdgcn_s_sleep(1); \
    if ((++_sp & 255u) == 0u) { if (xb_ld(&(bar)[XB_TMO])) break; if (_sp > XB_SPIN_CAP) { atomicAdd(&(bar)[XB_TMO], 1u); break; } } } } while (0)

struct XcdBarrier {
    unsigned* bar; unsigned x;
    volatile LAS unsigned* st;
};

__device__ __forceinline__ XcdBarrier xcd_barrier_post(unsigned* bar, volatile LAS unsigned* st) {
    XcdBarrier b; b.bar = bar; b.x = xb_xcc_id(); b.st = st;
    if (threadIdx.x == 0) (void)xb_add(&bar[XB_XCNT(b.x)], 1u);
    return b;
}
__device__ __forceinline__ void xcd_barrier_complete(unsigned* bar, unsigned x, unsigned& nloc, unsigned& nx) {
    const unsigned G = gridDim.x * gridDim.y * gridDim.z;
    unsigned sum, cnt, mine, sp = 0u;
    for (;;) {
        sum = 0u; cnt = 0u; mine = 0u;
#pragma unroll
        for (unsigned j = 0; j < 16; ++j) { const unsigned c = xb_ld(&bar[XB_XCNT(j)]); sum += c; cnt += (c > 0u) ? 1u : 0u; mine = (j == x) ? c : mine; }
        if (sum == G) break;
        __builtin_amdgcn_s_sleep(1);
        if ((++sp & 255u) == 0u) { if (xb_ld(&bar[XB_TMO])) break; if (sp > XB_SPIN_CAP) { atomicAdd(&bar[XB_TMO], 1u); break; } }
    }
    nloc = mine > 0u ? mine : 1u; nx = cnt > 0u ? cnt : 1u;
}

__device__ __forceinline__ void xcd_barrier(const XcdBarrier& b) {
    asm volatile("s_waitcnt vmcnt(0)" ::: "memory");
    __syncthreads();
    if (threadIdx.x == 0) {
        unsigned* bar = b.bar;
        __builtin_amdgcn_s_waitcnt(0);
        unsigned nloc = b.st[0], nx = b.st[1];
        if (nloc == 0u) { xcd_barrier_complete(bar, b.x, nloc, nx); b.st[0] = nloc; b.st[1] = nx; }
        const unsigned old = xb_add(&bar[XB_XSUB(b.x)], 1u);
        const unsigned gen = old / nloc;
        if (old + 1u == (gen + 1u) * nloc) {
            __builtin_amdgcn_fence(__ATOMIC_RELEASE, "agent");
            asm volatile("s_waitcnt vmcnt(0)" ::: "memory");
            const unsigned og = xb_add(&bar[XB_TOP], 1u);
            const unsigned tg = og / nx;
            if (og + 1u == (tg + 1u) * nx) xb_add(&bar[XB_TOPGEN], 1u);
            else XB_SPIN(xb_ld(&bar[XB_TOPGEN]) == tg, bar);
            __builtin_amdgcn_fence(__ATOMIC_ACQUIRE, "agent");
            xb_add(&bar[XB_XGEN(b.x)], 1u);
            asm volatile("s_waitcnt vmcnt(0)" ::: "memory");
        } else {
            XB_SPIN(xb_ld(&bar[XB_XGEN(b.x)]) == gen, bar);
            __builtin_amdgcn_fence(__ATOMIC_ACQUIRE, "agent");
            asm volatile("s_waitcnt vmcnt(0)" ::: "memory");
        }
    }
    __syncthreads();
}

struct Frame {
    LAS unsigned char* lds;
    volatile LAS unsigned* MISC;
    int tid, lane, wave;
    int vcu, G;
};
struct Args { const float* in[15]; float* out; unsigned char* ws; int nphase; int pad; };
typedef __attribute__((address_space(4))) const unsigned char* kargp_t;
__device__ __forceinline__ kargp_t kargs() { kargp_t p = (kargp_t)__builtin_amdgcn_kernarg_segment_ptr(); asm volatile("" : "+s"(p)); return p; }
typedef const float* cfp_t; typedef float* fp_t; typedef unsigned char* ucp_t;
#define CAS4 __attribute__((address_space(4)))
__device__ __forceinline__ const float* kin(int i) { return *(const CAS4 cfp_t*)(kargs() + 8 * i); }
__device__ __forceinline__ float* kout() { return *(const CAS4 fp_t*)(kargs() + 120); }
__device__ __forceinline__ unsigned char* kws() { return *(const CAS4 ucp_t*)(kargs() + 128); }
static_assert(sizeof(Args) == 144, "Args layout");
#define T_x()            kin(0)
#define T_norm_mix_g()   kin(1)
#define T_w_in()         kin(2)
#define T_q_norm_g()     kin(3)
#define T_k_norm_g()     kin(4)
#define T_conv_w()       kin(5)
#define T_attn_out_g()   kin(6)
#define T_conv_out_g()   kin(7)
#define T_w_out()        kin(8)
#define T_norm_ffn_g()   kin(9)
#define T_w_query()      kin(10)
#define T_sub_keys()     kin(11)
#define T_w_down()       kin(12)
#define T_w_up()         kin(13)
#define T_norm_final_g() kin(14)
#define T_WD()   ((bf16*)(kws() + WS_WD))
#define T_H()    ((bf16*)(kws() + WS_H))
#define T_GM()   ((bf16*)(kws() + WS_G))
#define T_PROJ() ((bf16*)(kws() + WS_PROJ))
#define T_Y()    ((bf16*)(kws() + WS_Y))
#define T_WIN()  ((bf16*)(kws() + WS_WIN))
#define T_WSC()  ((bf16*)(kws() + WS_WSC))
#define T_WUP()  ((bf16*)(kws() + WS_WUP))
#define T_WOUT() ((bf16*)(kws() + WS_WOUT))
#define T_SC()   ((float*)(kws() + WS_SC))
typedef unsigned long long u64;
__device__ __forceinline__ float bflo(unsigned w) { return __uint_as_float(w << 16); }
__device__ __forceinline__ float bfhi(unsigned w) { return __uint_as_float(w & 0xffff0000u); }
__device__ __forceinline__ float wave_sum(float v) {
#pragma unroll
    for (int o = 1; o < 64; o <<= 1) v += __shfl_xor(v, o);
    return v;
}
__device__ __forceinline__ void p0_transpose_item(const float* W, int K, int N, bf16* WT, LAS float* scr, int item, int lane) {
    const int nblk = N / 32, kb = item / nblk, nb = item % nblk, k0 = 64 * kb, n0 = 32 * nb;
#pragma unroll 8
    for (int i = 0; i < 32; ++i) { const int kk = 2 * i + (lane >> 5); scr[kk * 33 + (lane & 31)] = W[(size_t)(k0 + kk) * N + n0 + (lane & 31)]; }
    LDS_WAIT(); asm volatile("" ::: "memory");
    const int c = lane & 7;
#pragma unroll
    for (int j = 0; j < 4; ++j) { const int n = (lane >> 3) + 8 * j; const LAS float* s = scr + (8 * c) * 33 + n;
        v4u o; o.x = pk2(s[0 * 33], s[1 * 33]); o.y = pk2(s[2 * 33], s[3 * 33]); o.z = pk2(s[4 * 33], s[5 * 33]); o.w = pk2(s[6 * 33], s[7 * 33]);
        *(GAS v4u*)(WT + (size_t)(n0 + n) * K + k0 + 8 * c) = o; }
    LDS_WAIT(); asm volatile("" ::: "memory");
}
__device__ __forceinline__ void rms_row_to_bf16(const float* xrow, const float* g, bf16* orow, int lane) {
    const GAS f32x4* xr = (const GAS f32x4*)xrow + lane;
    f32x4 v[16]; float s = 0.f;
#pragma unroll
    for (int j = 0; j < 16; ++j) { v[j] = xr[64 * j]; s += (v[j].x * v[j].x + v[j].y * v[j].y) + (v[j].z * v[j].z + v[j].w * v[j].w); }
    const float r = 1.0f / sqrtf(wave_sum(s) * (1.f / DM) + EPS);
    const GAS f32x4* gr = (const GAS f32x4*)g + lane;
    GAS u64* o8 = (GAS u64*)orow + lane;
#pragma unroll
    for (int j = 0; j < 16; ++j) { const f32x4 gg = gr[64 * j];
        o8[64 * j] = (u64)pk2(v[j].x * r * gg.x, v[j].y * r * gg.y) | ((u64)pk2(v[j].z * r * gg.z, v[j].w * r * gg.w) << 32); }
}
__device__ __forceinline__ void rms_row_inplace(float* xrow, const float* g, int lane) {
    GAS f32x4* xr = (GAS f32x4*)xrow + lane;
    f32x4 v[16]; float s = 0.f;
#pragma unroll
    for (int j = 0; j < 16; ++j) { v[j] = xr[64 * j]; s += (v[j].x * v[j].x + v[j].y * v[j].y) + (v[j].z * v[j].z + v[j].w * v[j].w); }
    const float r = 1.0f / sqrtf(wave_sum(s) * (1.f / DM) + EPS);
    const GAS f32x4* gr = (const GAS f32x4*)g + lane;
#pragma unroll
    for (int j = 0; j < 16; ++j) { const f32x4 gg = gr[64 * j]; f32x4 o; o.x = v[j].x * r * gg.x; o.y = v[j].y * r * gg.y; o.z = v[j].z * r * gg.z; o.w = v[j].w * r * gg.w; xr[64 * j] = o; }
}
__device__ __forceinline__ void p0_premul_item(Frame& F, int item, const float* sub_keys, const float* w_query, bf16* WSC) {
    constexpr int LDP = 132;
    LAS float* Ks = (LAS float*)(F.lds + RING_OFF);
    LAS float* Ws = Ks + 128 * LDP;
    const int hp = item >> 6, k0 = (item & 63) * 64, tid = F.tid;
    const float* kg = sub_keys + (size_t)hp * 128 * 128;
#pragma unroll
    for (int i = 0; i < 8; ++i) { const int e = tid + 512 * i, r = e >> 5, c4 = e & 31; const f32x4 v = *(const GAS f32x4*)(kg + (size_t)r * 128 + c4 * 4); *(LAS f32x4*)(Ks + r * LDP + c4 * 4) = v; }
#pragma unroll
    for (int i = 0; i < 4; ++i) { const int e = tid + 512 * i, r = e >> 5, c4 = e & 31; const f32x4 v = *(const GAS f32x4*)(w_query + (size_t)(k0 + r) * PQ + hp * 128 + c4 * 4); *(LAS f32x4*)(Ws + r * LDP + c4 * 4) = v; }
    __syncthreads();
    const int ky = tid & 31, kx = tid >> 5;
    float acc[4][4];
#pragma unroll
    for (int i = 0; i < 4; ++i)
#pragma unroll
        for (int j = 0; j < 4; ++j) acc[i][j] = 0.f;
#pragma unroll 4
    for (int d = 0; d < 128; d += 4) {
        f32x4 a[4], b[4];
#pragma unroll
        for (int i = 0; i < 4; ++i) a[i] = *(const LAS f32x4*)(Ks + (ky + 32 * i) * LDP + d);
#pragma unroll
        for (int j = 0; j < 4; ++j) b[j] = *(const LAS f32x4*)(Ws + (kx + 16 * j) * LDP + d);
#pragma unroll
        for (int i = 0; i < 4; ++i)
#pragma unroll
            for (int j = 0; j < 4; ++j) acc[i][j] += (a[i].x * b[j].x + a[i].y * b[j].y) + (a[i].z * b[j].z + a[i].w * b[j].w);
    }
#pragma unroll
    for (int i = 0; i < 4; ++i)
#pragma unroll
        for (int j = 0; j < 4; ++j) WSC[(size_t)(hp * 128 + ky + 32 * i) * DM + k0 + kx + 16 * j] = (bf16)f2bf(acc[i][j]);
    __syncthreads();
}
__device__ __forceinline__ void p0_prologue(Frame& F) {
    const int gw = F.vcu * NWAVES + F.wave, NGW = F.G * NWAVES;
    { const float* sk = T_sub_keys(); const float* wq = T_w_query(); bf16* wsc = T_WSC();
      for (int it = F.vcu; it < 16 * 64; it += F.G) p0_premul_item(F, it, sk, wq, wsc); }
    LAS float* scr = (LAS float*)(F.lds + RING_OFF + F.wave * 16384);
    constexpr int I_IN = (DM / 64) * (IN_COLS / 32), I_OUT = (DM / 64) * (DM / 32);
    { const float* w_in = T_w_in(); const float* w_out = T_w_out(); bf16* WIN = T_WIN(); bf16* WOUT = T_WOUT();
    for (int it = gw; it < I_IN + I_OUT; it += NGW) {
        if (it < I_IN) p0_transpose_item(w_in, DM, IN_COLS, WIN, scr, it, F.lane);
        else p0_transpose_item(w_out, DM, DM, WOUT, scr, it - I_IN, F.lane);
    } }
    { const float* w_down = T_w_down(); bf16* WD = T_WD(); const size_t n8 = (size_t)NEXP * DM / 8, stride = (size_t)F.G * 512;
      for (size_t i = (size_t)F.vcu * 512 + F.tid; i < n8; i += stride) {
          const f32x4 a = *(const GAS f32x4*)(w_down + i * 8), b = *(const GAS f32x4*)(w_down + i * 8 + 4);
          v4u o; o.x = pk2(a.x, a.y); o.y = pk2(a.z, a.w); o.z = pk2(b.x, b.y); o.w = pk2(b.z, b.w);
          *(GAS v4u*)(WD + i * 8) = o; } }
    { const float* x = T_x(); const float* g = T_norm_mix_g(); bf16* H = T_H();
      for (int m = gw; m < M; m += NGW) rms_row_to_bf16(x + (size_t)m * DM, g, H + (size_t)m * DM, F.lane); }
}
__device__ __forceinline__ void unpack8(const v4u w, float (&y)[8]) { y[0] = bflo(w.x); y[1] = bfhi(w.x); y[2] = bflo(w.y); y[3] = bfhi(w.y); y[4] = bflo(w.z); y[5] = bfhi(w.z); y[6] = bflo(w.w); y[7] = bfhi(w.w); }
__device__ __forceinline__ v4u pack8(const float (&y)[8]) { v4u o; o.x = pk2(y[0], y[1]); o.y = pk2(y[2], y[3]); o.z = pk2(y[4], y[5]); o.w = pk2(y[6], y[7]); return o; }
__device__ __forceinline__ void p2_qk_token(Frame& F, int t, const float (&inv)[8], bf16* PROJ, const float* q_norm_g, const float* k_norm_g) {
    const int lane = F.lane, lp = lane & 15, s = t & (SEQ - 1);
    const bool colpart = (lp >> 3) != 0, first = ((lp >> 2) & 1) == 0;
    const float pos = (float)(colpart ? (s & (GRID_W - 1)) : (s / GRID_W));
    float cs[8], sn[8];
#pragma unroll
    for (int e = 0; e < 8; ++e) { const float ang = pos * inv[e]; float rev = ang * 0.15915494309189535f; rev = rev - floorf(rev); cs[e] = __builtin_amdgcn_cosf(rev); sn[e] = __builtin_amdgcn_sinf(rev); }
    bf16* prow = PROJ + (size_t)t * IN_COLS;
#pragma unroll
    for (int i = 0; i < 5; ++i) {
        int c = lane + 64 * i; asm volatile("" : "+v"(c));
        const v4u raw = *(const GAS v4u*)(prow + 8 * c);
        float y[8]; unpack8(raw, y);
        float ss = 0.f;
#pragma unroll
        for (int e = 0; e < 8; ++e) ss += y[e] * y[e];
        ss += __shfl_xor(ss, 1); ss += __shfl_xor(ss, 2); ss += __shfl_xor(ss, 4); ss += __shfl_xor(ss, 8);
        const float r = 1.0f / sqrtf(ss * (1.f / HD) + EPS);
        const float* g = (c < 256 ? q_norm_g : k_norm_g) + 8 * lp;
        const f32x4 g0 = *(const GAS f32x4*)g, g1 = *(const GAS f32x4*)(g + 4);
        const float gg[8] = {g0.x, g0.y, g0.z, g0.w, g1.x, g1.y, g1.z, g1.w};
        float o[8];
#pragma unroll
        for (int e = 0; e < 8; ++e) y[e] = y[e] * r * gg[e];
#pragma unroll
        for (int e = 0; e < 8; ++e) { const float p = __shfl_xor(y[e], 4); o[e] = y[e] * cs[e] + (first ? -p : p) * sn[e]; }
        *(GAS v4u*)(prow + 8 * c) = pack8(o);
        asm volatile("" ::: "memory");
    }
}
__device__ __forceinline__ void p2_conv_token(Frame& F, int t, const bf16* PROJ, bf16* Y, const float* conv_w, const float* conv_out_g) {
    const int lane = F.lane, s = t & (SEQ - 1);
    const bool hasL = s != 0, hasR = s != SEQ - 1;
    const bf16* r0 = PROJ + (size_t)t * IN_COLS;
    float o[4][8]; float ss = 0.f;
#pragma unroll
    for (int i = 0; i < 4; ++i) {
        int col = 8 * (lane + 64 * i); asm volatile("" : "+v"(col));
        const v4u z = {0u, 0u, 0u, 0u};
        const v4u cx0 = *(const GAS v4u*)(r0 + C_CX + col), gc0 = *(const GAS v4u*)(r0 + C_GC + col), gb0 = *(const GAS v4u*)(r0 + C_GB + col);
        const v4u cxL = hasL ? *(const GAS v4u*)(r0 - IN_COLS + C_CX + col) : z, gcL = hasL ? *(const GAS v4u*)(r0 - IN_COLS + C_GC + col) : z;
        const v4u cxR = hasR ? *(const GAS v4u*)(r0 + IN_COLS + C_CX + col) : z, gcR = hasR ? *(const GAS v4u*)(r0 + IN_COLS + C_GC + col) : z;
        float a0[8], b0[8], gb[8], aL[8], bL[8], aR[8], bR[8];
        unpack8(cx0, a0); unpack8(gc0, b0); unpack8(gb0, gb); unpack8(cxL, aL); unpack8(gcL, bL); unpack8(cxR, aR); unpack8(gcR, bR);
        const float* w = conv_w + col;
        const f32x4 w0a = *(const GAS f32x4*)w, w0b = *(const GAS f32x4*)(w + 4), w1a = *(const GAS f32x4*)(w + CONV_W), w1b = *(const GAS f32x4*)(w + CONV_W + 4), w2a = *(const GAS f32x4*)(w + 2 * CONV_W), w2b = *(const GAS f32x4*)(w + 2 * CONV_W + 4);
        const float w0[8] = {w0a.x, w0a.y, w0a.z, w0a.w, w0b.x, w0b.y, w0b.z, w0b.w}, w1[8] = {w1a.x, w1a.y, w1a.z, w1a.w, w1b.x, w1b.y, w1b.z, w1b.w}, w2[8] = {w2a.x, w2a.y, w2a.z, w2a.w, w2b.x, w2b.y, w2b.z, w2b.w};
#pragma unroll
        for (int e = 0; e < 8; ++e) { const float cv = gb[e] * ((bL[e] * aL[e]) * w0[e] + (b0[e] * a0[e]) * w1[e] + (bR[e] * aR[e]) * w2[e]); o[i][e] = cv; ss += cv * cv; }
        asm volatile("" ::: "memory");
    }
    const float r = 1.0f / sqrtf(wave_sum(ss) * (1.f / CONV_W) + EPS);
    bf16* yrow = Y + (size_t)t * DM + ATTN_W;
#pragma unroll
    for (int i = 0; i < 4; ++i) { int col = 8 * (lane + 64 * i); asm volatile("" : "+v"(col));
        const f32x4 g0 = *(const GAS f32x4*)(conv_out_g + col), g1 = *(const GAS f32x4*)(conv_out_g + col + 4);
        const float gg[8] = {g0.x, g0.y, g0.z, g0.w, g1.x, g1.y, g1.z, g1.w};
        float y[8];
#pragma unroll
        for (int e = 0; e < 8; ++e) y[e] = o[i][e] * r * gg[e];
        *(GAS v4u*)(yrow + col) = pack8(y); }
}
__device__ __forceinline__ void p3b_token(Frame& F, int t, bf16* Y, const float* attn_out_g) {
    const int lane = F.lane;
    bf16* yrow = Y + (size_t)t * DM;
    float v[4][8]; float ss = 0.f;
#pragma unroll
    for (int i = 0; i < 4; ++i) { const v4u w = *(const GAS v4u*)(yrow + 8 * (lane + 64 * i)); unpack8(w, v[i]);
#pragma unroll
        for (int e = 0; e < 8; ++e) ss += v[i][e] * v[i][e]; }
    const float r = 1.0f / sqrtf(wave_sum(ss) * (1.f / ATTN_W) + EPS);
#pragma unroll
    for (int i = 0; i < 4; ++i) { int col = 8 * (lane + 64 * i); asm volatile("" : "+v"(col));
        const f32x4 g0 = *(const GAS f32x4*)(attn_out_g + col), g1 = *(const GAS f32x4*)(attn_out_g + col + 4);
        const float gg[8] = {g0.x, g0.y, g0.z, g0.w, g1.x, g1.y, g1.z, g1.w};
        float y[8];
#pragma unroll
        for (int e = 0; e < 8; ++e) y[e] = v[i][e] * r * gg[e];
        *(GAS v4u*)(yrow + col) = pack8(y); }
}
__device__ __forceinline__ unsigned fkey(float f) { const unsigned u = __float_as_uint(f); return u ^ ((u >> 31) ? 0xFFFFFFFFu : 0x80000000u); }
__device__ __forceinline__ int popc64(u64 m) { return __builtin_popcountll(m); }
__device__ __forceinline__ int lanes_below(u64 m) { return (int)__builtin_amdgcn_mbcnt_hi((unsigned)(m >> 32), __builtin_amdgcn_mbcnt_lo((unsigned)m, 0u)); }
template <int NS> __device__ __forceinline__ unsigned topk_thresh(const unsigned (&k)[NS]) {
    unsigned T = 0u;
    for (int bit = 31; bit >= 0; --bit) {
        const unsigned cand = T | (1u << bit); int cnt = 0;
#pragma unroll
        for (int j = 0; j < NS; ++j) cnt += popc64(__ballot(k[j] >= cand));
        if (cnt >= PTOPK) { T = cand; if (cnt == PTOPK) break; }
    }
    return T;
}
template <int NS> __device__ __forceinline__ void topk_select(const unsigned (&k)[NS], unsigned T, bool (&sel)[NS], int (&pos)[NS]) {
    int ngt = 0;
#pragma unroll
    for (int j = 0; j < NS; ++j) ngt += popc64(__ballot(k[j] > T));
    int need = PTOPK - ngt, eqbase = 0, base = 0;
#pragma unroll
    for (int j = 0; j < NS; ++j) {
        const bool eq = k[j] == T; const u64 me = __ballot(eq);
        const bool s = (k[j] > T) || (eq && (eqbase + lanes_below(me)) < need);
        eqbase += popc64(me);
        const u64 ms = __ballot(s);
        sel[j] = s; pos[j] = base + lanes_below(ms); base += popc64(ms);
    }
}
__device__ __forceinline__ void p5_topk_phase(Frame& F) {
    LAS float* rowbuf = (LAS float*)(F.lds + RING_OFF);
    LAS float* tk = (LAS float*)(F.lds + TK_OFF + F.wave * 512);
    LAS int* tki = (LAS int*)tk;
    const int lane = F.lane, tid = F.tid, w = F.wave;
    const float* SC = T_SC(); bf16* GM = T_GM();
    for (int u = tid; u < 2 * NEXP / 4; u += NWAVES * 64) ((LAS f32x4*)rowbuf)[u] = (f32x4){0.f, 0.f, 0.f, 0.f};
    __syncthreads();
    int it = 0;
    for (int t = F.vcu; t < M; t += F.G, ++it) {
        LAS float* row = rowbuf + (it & 1) * NEXP;
        const float* sc = SC + (size_t)t * PQ + w * 256;
        float v[4]; v[0] = sc[lane]; v[1] = sc[64 + lane]; v[2] = sc[128 + lane]; v[3] = sc[192 + lane];
#pragma unroll
        for (int p = 0; p < 2; ++p) {
            unsigned k[2] = {fkey(v[2 * p]), fkey(v[2 * p + 1])}; bool sel[2]; int pos[2];
            const unsigned T = topk_thresh<2>(k); topk_select<2>(k, T, sel, pos);
            if (sel[0]) { tk[32 * p + pos[0]] = v[2 * p]; tki[32 * p + 16 + pos[0]] = lane; }
            if (sel[1]) { tk[32 * p + pos[1]] = v[2 * p + 1]; tki[32 * p + 16 + pos[1]] = 64 + lane; }
        }
        LDS_WAIT(); asm volatile("" ::: "memory");
        float cs[4]; unsigned ck[4]; bool csel[4]; int cpos[4];
#pragma unroll
        for (int j = 0; j < 4; ++j) { const int c = 64 * j + lane; cs[j] = tk[c >> 4] + tk[32 + (c & 15)]; ck[j] = fkey(cs[j]); }
        { const unsigned T = topk_thresh<4>(ck); topk_select<4>(ck, T, csel, cpos); }
#pragma unroll
        for (int j = 0; j < 4; ++j) if (csel[j]) { const int c = 64 * j + lane; tk[64 + cpos[j]] = cs[j]; tki[80 + cpos[j]] = tki[16 + (c >> 4)] * NKEYS + tki[48 + (c & 15)]; }
        LDS_WAIT(); asm volatile("" ::: "memory");
        float mx = tk[64];
#pragma unroll
        for (int q = 1; q < 16; ++q) mx = fmaxf(mx, tk[64 + q]);
        float den = 0.f;
#pragma unroll
        for (int q = 0; q < 16; ++q) den += __expf(tk[64 + q] - mx);
        if (lane < 16) { const float gate = __expf(tk[64 + lane] - mx) / den; const int idx = tki[80 + lane];
            __hip_atomic_fetch_add(row + idx, gate, __ATOMIC_RELAXED, __HIP_MEMORY_SCOPE_WORKGROUP); }
        LDS_WAIT();
        __syncthreads();
        bf16* grow = GM + (size_t)t * NEXP;
#pragma unroll
        for (int j = 0; j < 4; ++j) { const int c = tid + 512 * j;
            const f32x4 a = *(const LAS f32x4*)(row + 8 * c), b = *(const LAS f32x4*)(row + 8 * c + 4);
            v4u o; o.x = pk2(a.x, a.y); o.y = pk2(a.z, a.w); o.z = pk2(b.x, b.y); o.w = pk2(b.z, b.w);
            *(GAS v4u*)(grow + 8 * c) = o;
            if (((__float_as_uint(a.x) | __float_as_uint(a.y) | __float_as_uint(a.z) | __float_as_uint(a.w) | __float_as_uint(b.x) | __float_as_uint(b.y) | __float_as_uint(b.z) | __float_as_uint(b.w)) << 1) != 0u) { *(LAS f32x4*)(row + 8 * c) = (f32x4){0.f, 0.f, 0.f, 0.f}; *(LAS f32x4*)(row + 8 * c + 4) = (f32x4){0.f, 0.f, 0.f, 0.f}; } }
    }
    LDS_WAIT();
    __syncthreads();
}
__device__ __forceinline__ void p6_wup_transpose(Frame& F) {
    const int gw = F.vcu * NWAVES + F.wave, NGW = F.G * NWAVES;
    LAS float* scr = (LAS float*)(F.lds + RING_OFF + F.wave * 16384);
    constexpr int I_UP = (NEXP / 64) * (DM / 32);
    { const float* w_up = T_w_up(); bf16* WUP = T_WUP();
      for (int it = gw; it < I_UP; it += NGW) p0_transpose_item(w_up, NEXP, DM, WUP, scr, it, F.lane); }
    VM_WAIT(); LDS_WAIT();
    __syncthreads();
}

__global__ void __launch_bounds__(NWAVES * 64, 2) hymba_fwd(Args args) {
    extern __shared__ __attribute__((aligned(16))) unsigned char lds[];
    Frame F;
    F.lds = (LAS unsigned char*)lds;
    F.MISC = (volatile LAS unsigned*)(F.lds + MISC_OFF);
    F.wave = __builtin_amdgcn_readfirstlane((int)threadIdx.x >> 6);
#define FRESH_IDS() do { int t_ = (F.wave << 6) | (int)__builtin_amdgcn_mbcnt_hi(~0u, __builtin_amdgcn_mbcnt_lo(~0u, 0u)); asm volatile("" : "+v"(t_)); F.tid = t_; F.lane = t_ & 63; } while (0)
    FRESH_IDS();
    F.G = gridDim.x; { const int bx = blockIdx.x; F.vcu = (F.G % 8 == 0) ? (bx % 8) * (F.G / 8) + bx / 8 : bx; }
    for (int u = F.tid; u < (LDS_BYTES - LDSCTL_OFF) / 4; u += NWAVES * 64) ((LAS unsigned*)(F.lds + LDSCTL_OFF))[u] = 0u;
    __syncthreads();
    XcdBarrier bar = xcd_barrier_post((unsigned*)(kws() + WS_CTL) + CW_BAR, F.MISC + 8);
#define GRID_BAR() do { xcd_barrier(bar); FRESH_IDS(); } while (0)
    const int gw = F.vcu * NWAVES + F.wave, NGW = F.G * NWAVES;
    const int nph = *(const CAS4 int*)(kargs() + 136);

    p0_prologue(F);
    GRID_BAR();
    {
        pg8::Gemm g{T_H(), T_WIN(), M, IN_COLS, DM}; pg8::StaticOrder S; S.init(M, IN_COLS, F.G, (int)blockIdx.x);
        pg8::EpiBf16<0> E{T_PROJ(), IN_COLS, nullptr, 0, 0, 1.f};
        pg8::gemm_phase<pg8::EpiBf16<0>, pg8::StaticOrder, true, true>(F.lds + RING_OFF, g, S, E, F.wave);
    }
    GRID_BAR();
    {
        float inv[8];
#pragma unroll
        for (int e = 0; e < 8; ++e) inv[e] = exp2f(-(float)(8 * (F.lane & 3) + e) * (13.287712379549449f / 32.0f));
        bf16* PROJ = T_PROJ(); const float* qg = T_q_norm_g(); const float* kg = T_k_norm_g();
        for (int t = gw; t < M; t += NGW) p2_qk_token(F, t, inv, PROJ, qg, kg);
    }
    {
        const bf16* PROJ = T_PROJ(); bf16* Y = T_Y(); const float* cw = T_conv_w(); const float* cg = T_conv_out_g();
        for (int t = gw; t < M; t += NGW) p2_conv_token(F, t, PROJ, Y, cw, cg);
    }
    GRID_BAR();
    if (nph > 3) {
        const attn128::bf16* P = (const attn128::bf16*)T_PROJ(); attn128::bf16* Yb = (attn128::bf16*)T_Y();
        for (int i = 0;; ++i) {
            int L;
            if (F.G == 256) { if (i >= 4) break; L = (F.vcu >> 5) * 128 + i * 32 + (F.vcu & 31); }
            else { L = i * F.G + F.vcu; if (L >= BATCH * NQH * (SEQ / 256)) break; }
            const int bkv = L >> 7, rem = L & 127, b = bkv >> 2, kvh = bkv & 3, h = kvh * 4 + (rem >> 5), qb = rem & 31;
            const size_t rowb = (size_t)b * SEQ;
            attn128::attn_dense_body<attn128::bf16>(P + (rowb + (size_t)qb * 256) * IN_COLS + C_Q + h * HD, P + rowb * IN_COLS + C_K + kvh * HD, P + rowb * IN_COLS + C_V + kvh * HD,
                                                     Yb + (rowb + (size_t)qb * 256) * DM + h * HD, SEQ, (char*)lds + RING_OFF, F.wave);
        }
        __syncthreads();
    }
    GRID_BAR();
    if (nph > 3) { bf16* Y = T_Y(); const float* ag = T_attn_out_g(); for (int t = gw; t < M; t += NGW) p3b_token(F, t, Y, ag); }
    else { bf16* Y = T_Y(); for (int t = gw; t < M; t += NGW) { bf16* yrow = Y + (size_t)t * DM;
#pragma unroll
            for (int i = 0; i < 4; ++i) *(GAS v4u*)(yrow + 8 * (F.lane + 64 * i)) = (v4u){0u, 0u, 0u, 0u}; } }
    GRID_BAR();
    {
        pg8::Gemm g{T_Y(), T_WOUT(), M, DM, DM}; pg8::StaticOrder S; S.init(M, DM, F.G, (int)blockIdx.x);
        pg8::EpiResF32 E{T_x(), kout(), DM};
        pg8::gemm_phase<pg8::EpiResF32, pg8::StaticOrder, true, true>(F.lds + RING_OFF, g, S, E, F.wave);
    }
    GRID_BAR();
    if (nph > 5) {
    { const float* x1 = kout(); const float* g = T_norm_ffn_g(); bf16* H = T_H();
      for (int m = gw; m < M; m += NGW) rms_row_to_bf16(x1 + (size_t)m * DM, g, H + (size_t)m * DM, F.lane); }
    GRID_BAR();
    {
        pg8::Gemm g{T_H(), T_WSC(), M, PQ, DM}; pg8::StaticOrder S; S.init(M, PQ, F.G, (int)blockIdx.x);
        pg8::EpiF32Plain E{T_SC(), PQ};
        pg8::gemm_phase<pg8::EpiF32Plain, pg8::StaticOrder, true, true>(F.lds + RING_OFF, g, S, E, F.wave);
    }
    GRID_BAR();
    p5_topk_phase(F);
    GRID_BAR();
    p6_wup_transpose(F);
    {
        pg8::Gemm g{T_H(), T_WD(), M, NEXP, DM}; pg8::StaticOrder S; S.init(M, NEXP, F.G, (int)blockIdx.x);
        pg8::EpiGeluGate E{T_GM(), NEXP};
        pg8::gemm_phase<pg8::EpiGeluGate, pg8::StaticOrder, true, true>(F.lds + RING_OFF, g, S, E, F.wave);
    }
    GRID_BAR();
    {
        pg8::Gemm g{T_GM(), T_WUP(), M, DM, NEXP}; pg8::StaticOrder S; S.init(M, DM, F.G, (int)blockIdx.x);
        float* o_ = kout(); pg8::EpiResF32 E{o_, o_, DM};
        pg8::gemm_phase<pg8::EpiResF32, pg8::StaticOrder, true, true>(F.lds + RING_OFF, g, S, E, F.wave);
    }
    GRID_BAR();
    }
    { float* o_ = kout(); const float* g = T_norm_final_g();
      for (int m = gw; m < M; m += NGW) rms_row_inplace(o_ + (size_t)m * DM, g, F.lane); }
#undef GRID_BAR
}

#ifndef HY_NPHASE
#define HY_NPHASE 9
#endif
extern "C" void kernel_launch(void* const* d_in, const int* in_sizes, int n_in, void* d_out, int out_size, void* d_ws, size_t ws_size, hipStream_t stream) {
    static int grid = 0;
    if (grid == 0) {
        if (n_in != 15 || in_sizes[0] != M * DM || out_size != M * DM || ws_size < WS_END) {
            fprintf(stderr, "kernel_launch: built for 15 inputs, x/out of %d floats, >= %zu bytes of workspace; got n_in %d, in0 %d, out %d, ws %zu; nothing launched\n", M * DM, (size_t)WS_END, n_in, n_in > 0 ? in_sizes[0] : -1, out_size, ws_size);
            grid = -1; return; }
        int dev = 0, cus = 0, per_cu = 0;
        if (hipGetDevice(&dev) != hipSuccess || hipDeviceGetAttribute(&cus, hipDeviceAttributeMultiprocessorCount, dev) != hipSuccess) { fprintf(stderr, "kernel_launch: device query failed\n"); grid = -1; return; }
        if (hipFuncSetAttribute((const void*)hymba_fwd, hipFuncAttributeMaxDynamicSharedMemorySize, LDS_BYTES) != hipSuccess) { fprintf(stderr, "kernel_launch: hipFuncSetAttribute failed\n"); grid = -1; return; }
        if (hipOccupancyMaxActiveBlocksPerMultiprocessor(&per_cu, (const void*)hymba_fwd, NWAVES * 64, LDS_BYTES) != hipSuccess || per_cu < 1)
            fprintf(stderr, "kernel_launch: note: occupancy query reports %d workgroups per CU\n", per_cu);
        (void)hipGetLastError();
        grid = cus;
    }
    if (grid < 0) return;
    if (hipMemsetAsync((char*)d_ws + WS_CTL, 0, CTL_ZERO_BYTES, stream) != hipSuccess) { fprintf(stderr, "kernel_launch: hipMemsetAsync failed\n"); return; }
    Args a{};
    for (int i = 0; i < 15; ++i) a.in[i] = (const float*)d_in[i];
    a.out = (float*)d_out; a.ws = (unsigned char*)d_ws; a.nphase = HY_NPHASE; a.pad = 0;
    hipLaunchKernelGGL(hymba_fwd, dim3(grid), dim3(NWAVES * 64), LDS_BYTES, stream, a);
    const hipError_t le = hipPeekAtLastError();
    if (le != hipSuccess) fprintf(stderr, "kernel_launch: launch failed: %s\n", hipGetErrorName(le));
}
```

```cpp
#include <hip/hip_runtime.h>
#include <hip/hip_bf16.h>
#include <cstdio>
#include <cstdint>
namespace pg8 {
#define PG8_LAS __attribute__((address_space(3)))
typedef unsigned short bf16_t;
typedef short bf16x8 __attribute__((ext_vector_type(8)));
typedef float f32x4 __attribute__((ext_vector_type(4)));
typedef unsigned u32x4 __attribute__((ext_vector_type(4)));
typedef int i32x4 __attribute__((ext_vector_type(4)));
typedef int i32x8 __attribute__((ext_vector_type(8)));
typedef int i32x6 __attribute__((ext_vector_type(6)));
typedef int i32x2 __attribute__((ext_vector_type(2)));
typedef float f32x16v __attribute__((ext_vector_type(16)));
typedef unsigned u32x2 __attribute__((ext_vector_type(2)));
constexpr int BM = 256, BK = 64, HALF = 128, HTB = HALF * BK * 2  , STAGE_BYTES = 8 * HTB, NXCD = 8, WGM = 8;

__host__ __device__ __forceinline__ int lds_byte(int r, int c) { const int st = (r >> 4) * 2 + (c >> 5), rr = r & 15, cc = c & 31, ob = rr * 64 + cc * 2; return st * 1024 + (ob ^ (((ob >> 9) & 1) << 5)); }
__host__ __device__ __forceinline__ void stage_rc(int b, int& R, int& C) { const int st = b / 1024, sb = b % 1024, swz = sb ^ (((sb >> 9) & 1) << 5); R = (st >> 1) * 16 + swz / 64; C = (st & 1) * 32 + (swz % 64) / 2; }
__host__ __device__ __forceinline__ int perm32(int rho) { const int n = rho >> 4, i = rho & 15; return 8 * (i >> 2) + 4 * n + (i & 3); }

struct Unit { int pm, pn; };
struct Gemm { const bf16_t* A; const bf16_t* Bt; int M, N, K; };

struct StaticOrder {
    int nM, nN, nwg, G, c;
    __host__ __device__ void init(int M, int N, int G_, int c_) { nM = M / BM; nN = N / BM; nwg = nM * nN; G = G_; c = c_; }
    __host__ __device__ bool next(int i, Unit& u) const {
        const long L = (long)i * G + c; if (L >= nwg) return false;
        int wgid = (int)L; { const int q = nwg / NXCD, r = nwg % NXCD, xcd = wgid % NXCD, off = wgid / NXCD; wgid = (xcd < r ? xcd * (q + 1) : r * (q + 1) + (xcd - r) * q) + off; }
        const int nig = WGM * nN, gid = wgid / nig, fm = gid * WGM, gsz = (nM - fm) < WGM ? (nM - fm) : WGM;
        u.pm = fm + ((wgid % nig) % gsz); u.pn = (wgid % nig) / gsz; return true;
    }
    __device__ __forceinline__ void a_ready(const Unit&) const {}
    __device__ __forceinline__ void done(const Unit&) const {}
};

__device__ __forceinline__ unsigned cvt_pk_bf16(float lo, float hi) { unsigned r; asm volatile("v_cvt_pk_bf16_f32 %0, %1, %2" : "=v"(r) : "v"(lo), "v"(hi)); return r; }
typedef float f32x2 __attribute__((ext_vector_type(2)));
__device__ __forceinline__ f32x2 gelu_pk(f32x2 v) {
    const f32x2 av = __builtin_elementwise_abs(v), d = av * 0.2316418882f + 1.0f;
    f32x2 t; t.x = __builtin_amdgcn_rcpf(d.x); t.y = __builtin_amdgcn_rcpf(d.y);
    f32x2 q = t * 0.5307027145f + (-0.7265760135f); q = q * t + 0.7107068705f; q = q * t + (-0.142248368f); q = q * t + 0.127414796f; q = q * t;
    const f32x2 s = (v * v) * (-0.72134752044f);
    f32x2 e; e.x = __builtin_amdgcn_exp2f(s.x); e.y = __builtin_amdgcn_exp2f(s.y);
    const f32x2 m = v * (q * e), r = v - m;
    f32x2 o; o.x = v.x < 0.f ? m.x : r.x; o.y = v.y < 0.f ? m.y : r.y; return o;
}

template <int ACT  > struct EpiBf16 {
    static constexpr bool PERM = true, AFTER_DRAIN = false; static_assert(ACT == 0 || ACT == 1, "EpiBf16: ACT is 0 (none) or 1 (gelu_pk)");
    bf16_t* O; int ldc; const float* bias; int split_cols; size_t split_stride; float scale0;
    __device__ __forceinline__ void operator()(const f32x4 (&acc)[2][2][4][2], const Unit& u, int wr, int wc, int fr, int fq) const {
        const int row0 = u.pm * BM + wr * 64 + fr; int colt = u.pn * BM; bf16_t* base = O;
        float sc = 1.f; if (split_cols) { const int t = colt / split_cols; base += (size_t)t * split_stride; colt -= t * split_cols; if (t == 0) sc = scale0; }
        const int col0 = colt + wc * 32 + 8 * fq, bcol0 = u.pn * BM + wc * 32 + 8 * fq;
        f32x4 bv[2][2];
#pragma unroll
        for (int bj = 0; bj < 2; ++bj)
#pragma unroll
            for (int n = 0; n < 2; ++n) bv[bj][n] = bias ? *(const f32x4*)(bias + bcol0 + bj * HALF + 4 * n) : (f32x4){0.f, 0.f, 0.f, 0.f};
#pragma unroll
        for (int ai = 0; ai < 2; ++ai)
#pragma unroll
            for (int m = 0; m < 4; ++m) { bf16_t* rowp = base + (size_t)(row0 + ai * HALF + m * 16) * ldc + col0;
#pragma unroll
                for (int bj = 0; bj < 2; ++bj) { f32x4 v0 = acc[ai][bj][m][0] + bv[bj][0], v1 = acc[ai][bj][m][1] + bv[bj][1];
                    if (ACT == 1) { f32x2 a = gelu_pk((f32x2){v0[0], v0[1]}), b = gelu_pk((f32x2){v0[2], v0[3]}), c = gelu_pk((f32x2){v1[0], v1[1]}), d = gelu_pk((f32x2){v1[2], v1[3]});
                        v0 = (f32x4){a.x, a.y, b.x, b.y}; v1 = (f32x4){c.x, c.y, d.x, d.y}; }
                    v0 = v0 * sc; v1 = v1 * sc; u32x4 w; w.x = cvt_pk_bf16(v0[0], v0[1]); w.y = cvt_pk_bf16(v0[2], v0[3]); w.z = cvt_pk_bf16(v1[0], v1[1]); w.w = cvt_pk_bf16(v1[2], v1[3]);
                    *(u32x4*)(rowp + bj * HALF) = w; } }
    }
};
struct EpiResF32 {
    static constexpr bool PERM = false, AFTER_DRAIN = false;
    const float* base; float* out; int ldc; float scale;
    __device__ __forceinline__ void operator()(const f32x4 (&acc)[2][2][4][2], const Unit& u, int wr, int wc, int fr, int fq) const {
        const int row0 = u.pm * BM + wr * 64 + fr, col0 = u.pn * BM + wc * 32 + 4 * fq;
#pragma unroll
        for (int ai = 0; ai < 2; ++ai)
#pragma unroll
            for (int m = 0; m < 4; ++m) { const size_t off = (size_t)(row0 + ai * HALF + m * 16) * ldc + col0;
                f32x4 b[2][2];
#pragma unroll
                for (int bj = 0; bj < 2; ++bj)
#pragma unroll
                    for (int n = 0; n < 2; ++n) b[bj][n] = *(const f32x4*)(base + off + bj * HALF + n * 16);
#pragma unroll
                for (int bj = 0; bj < 2; ++bj)
#pragma unroll
                    for (int n = 0; n < 2; ++n) *(f32x4*)(out + off + bj * HALF + n * 16) = b[bj][n] + acc[ai][bj][m][n] * scale;
                if (m & 1) asm volatile("" ::: "memory"); }
    }
};
struct EpiF32Plain {
    static constexpr bool PERM = false, AFTER_DRAIN = false;
    float* C; int ldc; const float* rowfac;
    __device__ __forceinline__ void operator()(const f32x4 (&acc)[2][2][4][2], const Unit& u, int wr, int wc, int fr, int fq) const {
        const int row0 = u.pm * BM + wr * 64 + fr, col0 = u.pn * BM + wc * 32 + 4 * fq;
#pragma unroll
        for (int ai = 0; ai < 2; ++ai)
#pragma unroll
            for (int m = 0; m < 4; ++m) { const int row = row0 + ai * HALF + m * 16; const float rf = rowfac[row]; float* rowp = C + (size_t)row * ldc + col0;
#pragma unroll
                for (int bj = 0; bj < 2; ++bj)
#pragma unroll
                    for (int n = 0; n < 2; ++n) *(f32x4*)(rowp + bj * HALF + n * 16) = acc[ai][bj][m][n] * rf; }
    }
};
struct EpiF32PlainI8 {
    static constexpr bool PERM = false, AFTER_DRAIN = false;
    float* C; int ldc; const float* rowfac; const float* colmax;
    __device__ __forceinline__ void operator()(const f32x4 (&acc)[2][2][4][2], const Unit& u, int wr, int wc, int fr, int fq) const {
        const int row0 = u.pm * BM + wr * 64 + fr, col0 = u.pn * BM + wc * 32 + 4 * fq;
        f32x4 cs[2][2];
#pragma unroll
        for (int bj = 0; bj < 2; ++bj)
#pragma unroll
            for (int n = 0; n < 2; ++n) cs[bj][n] = *(const f32x4*)(colmax + col0 + bj * HALF + n * 16) * (1.f / 127.f);
#pragma unroll
        for (int ai = 0; ai < 2; ++ai)
#pragma unroll
            for (int m = 0; m < 4; ++m) { const int row = row0 + ai * HALF + m * 16; const float rf = rowfac[row]; float* rowp = C + (size_t)row * ldc + col0;
#pragma unroll
                for (int bj = 0; bj < 2; ++bj)
#pragma unroll
                    for (int n = 0; n < 2; ++n) { const i32x4 iv = __builtin_bit_cast(i32x4, acc[ai][bj][m][n]); const f32x4 c = cs[bj][n] * rf;
                        *(f32x4*)(rowp + bj * HALF + n * 16) = (f32x4){(float)iv[0] * c[0], (float)iv[1] * c[1], (float)iv[2] * c[2], (float)iv[3] * c[3]}; } }
    }
};
struct EpiGeluGate {
    static constexpr bool PERM = true, AFTER_DRAIN = false;
    bf16_t* G; int ldc;
    __device__ __forceinline__ void operator()(const f32x4 (&acc)[2][2][4][2], const Unit& u, int wr, int wc, int fr, int fq) const {
        const int row0 = u.pm * BM + wr * 64 + fr, col0 = u.pn * BM + wc * 32 + 8 * fq;
#pragma unroll
        for (int ai = 0; ai < 2; ++ai) {
            u32x4 g[4][2];
#pragma unroll
            for (int m = 0; m < 4; ++m)
#pragma unroll
                for (int bj = 0; bj < 2; ++bj) g[m][bj] = *(const u32x4*)(G + (size_t)(row0 + ai * HALF + m * 16) * ldc + col0 + bj * HALF);
#pragma unroll
            for (int m = 0; m < 4; ++m)
#pragma unroll
                for (int bj = 0; bj < 2; ++bj) { const u32x4 gw = g[m][bj];
                    if ((gw.x | gw.y | gw.z | gw.w) != 0u) {
                        const f32x4 v0 = acc[ai][bj][m][0], v1 = acc[ai][bj][m][1];
                        const f32x2 a = gelu_pk((f32x2){v0[0], v0[1]}), b = gelu_pk((f32x2){v0[2], v0[3]}), c = gelu_pk((f32x2){v1[0], v1[1]}), d = gelu_pk((f32x2){v1[2], v1[3]});
                        u32x4 w;
                        w.x = cvt_pk_bf16(a.x * __uint_as_float(gw.x << 16), a.y * __uint_as_float(gw.x & 0xffff0000u));
                        w.y = cvt_pk_bf16(b.x * __uint_as_float(gw.y << 16), b.y * __uint_as_float(gw.y & 0xffff0000u));
                        w.z = cvt_pk_bf16(c.x * __uint_as_float(gw.z << 16), c.y * __uint_as_float(gw.z & 0xffff0000u));
                        w.w = cvt_pk_bf16(d.x * __uint_as_float(gw.w << 16), d.y * __uint_as_float(gw.w & 0xffff0000u));
                        *(u32x4*)(G + (size_t)(row0 + ai * HALF + m * 16) * ldc + col0 + bj * HALF) = w; } }
        }
    }
};
__device__ __forceinline__ unsigned pk4_fp8(float a, float b, float c, float d) {
    a = __builtin_fminf(__builtin_fmaxf(a, -448.f), 448.f); b = __builtin_fminf(__builtin_fmaxf(b, -448.f), 448.f); c = __builtin_fminf(__builtin_fmaxf(c, -448.f), 448.f); d = __builtin_fminf(__builtin_fmaxf(d, -448.f), 448.f);
    int w = 0; w = __builtin_amdgcn_cvt_pk_fp8_f32(a, b, w, false); w = __builtin_amdgcn_cvt_pk_fp8_f32(c, d, w, true); return (unsigned)w; }
struct EpiGeluGate8 {
    static constexpr bool PERM = true, AFTER_DRAIN = false;
    unsigned char* G; int ldc; float uscale;
    __device__ __forceinline__ void operator()(const f32x4 (&acc)[2][2][4][2], const Unit& u, int wr, int wc, int fr, int fq) const {
        const int row0 = u.pm * BM + wr * 64 + fr, col0 = u.pn * BM + wc * 32 + 8 * fq;
#pragma unroll
        for (int ai = 0; ai < 2; ++ai) {
            u32x2 g[4][2];
#pragma unroll
            for (int m = 0; m < 4; ++m)
#pragma unroll
                for (int bj = 0; bj < 2; ++bj) g[m][bj] = *(const u32x2*)(G + (size_t)(row0 + ai * HALF + m * 16) * ldc + col0 + bj * HALF);
#pragma unroll
            for (int m = 0; m < 4; ++m)
#pragma unroll
                for (int bj = 0; bj < 2; ++bj) { const u32x2 gw = g[m][bj];
                    if ((gw.x | gw.y) != 0u) {
                        const f32x4 v0 = acc[ai][bj][m][0] * uscale, v1 = acc[ai][bj][m][1] * uscale;
                        const f32x2 a = gelu_pk((f32x2){v0[0], v0[1]}), b = gelu_pk((f32x2){v0[2], v0[3]}), c = gelu_pk((f32x2){v1[0], v1[1]}), d = gelu_pk((f32x2){v1[2], v1[3]});
                        u32x2 w;
                        w.x = pk4_fp8(a.x * __builtin_amdgcn_cvt_f32_fp8((int)gw.x, 0), a.y * __builtin_amdgcn_cvt_f32_fp8((int)gw.x, 1), b.x * __builtin_amdgcn_cvt_f32_fp8((int)gw.x, 2), b.y * __builtin_amdgcn_cvt_f32_fp8((int)gw.x, 3));
                        w.y = pk4_fp8(c.x * __builtin_amdgcn_cvt_f32_fp8((int)gw.y, 0), c.y * __builtin_amdgcn_cvt_f32_fp8((int)gw.y, 1), d.x * __builtin_amdgcn_cvt_f32_fp8((int)gw.y, 2), d.y * __builtin_amdgcn_cvt_f32_fp8((int)gw.y, 3));
                        *(u32x2*)(G + (size_t)(row0 + ai * HALF + m * 16) * ldc + col0 + bj * HALF) = w; } }
        }
    }
};
struct EpiBf16I8 {
    static constexpr bool PERM = true, AFTER_DRAIN = false;
    bf16_t* O; int ldc; const float* rowscale; const float* colmax;
    __device__ __forceinline__ void operator()(const f32x4 (&acc)[2][2][4][2], const Unit& u, int wr, int wc, int fr, int fq) const {
        const int row0 = u.pm * BM + wr * 64 + fr, col0 = u.pn * BM + wc * 32 + 8 * fq;
        f32x4 cs[2][2];
#pragma unroll
        for (int bj = 0; bj < 2; ++bj)
#pragma unroll
            for (int n = 0; n < 2; ++n) cs[bj][n] = *(const f32x4*)(colmax + col0 + bj * HALF + 4 * n) * (1.f / 127.f);
#pragma unroll
        for (int ai = 0; ai < 2; ++ai)
#pragma unroll
            for (int m = 0; m < 4; ++m) { const int row = row0 + ai * HALF + m * 16; const float sc = rowscale[row]; bf16_t* rowp = O + (size_t)row * ldc + col0;
#pragma unroll
                for (int bj = 0; bj < 2; ++bj) { const i32x4 i0 = __builtin_bit_cast(i32x4, acc[ai][bj][m][0]), i1 = __builtin_bit_cast(i32x4, acc[ai][bj][m][1]); const f32x4 c0 = cs[bj][0] * sc, c1 = cs[bj][1] * sc;
                    u32x4 w; w.x = cvt_pk_bf16((float)i0[0] * c0[0], (float)i0[1] * c0[1]); w.y = cvt_pk_bf16((float)i0[2] * c0[2], (float)i0[3] * c0[3]); w.z = cvt_pk_bf16((float)i1[0] * c1[0], (float)i1[1] * c1[1]); w.w = cvt_pk_bf16((float)i1[2] * c1[2], (float)i1[3] * c1[3]);
                    *(u32x4*)(rowp + bj * HALF) = w; } }
    }
};
struct EpiResBf16I8 {
    static constexpr bool PERM = true, AFTER_DRAIN = false;
    static constexpr int MIDK_TAB = 147456 + 8192;
    const bf16_t* base; bf16_t* out; int ldc; const float* rowscale; const float* colmax;
    const float* rho;
    __device__ __forceinline__ void midk_pre(const Unit& u, PG8_LAS unsigned char* lds, int wid) const {
        unsigned z_ = 0u; asm volatile("" : "+v"(z_)); const int tid = (wid << 6) | (int)__builtin_amdgcn_mbcnt_hi(~0u, __builtin_amdgcn_mbcnt_lo(~0u, z_));
        if (tid < BM) ((PG8_LAS float*)(lds + MIDK_TAB))[tid] = rho[u.pm * BM + tid];
    }
    __device__ __forceinline__ void midk(f32x4 (&acc)[2][2][4][2], PG8_LAS unsigned char* lds, int wr, int fr) const {
        const PG8_LAS float* tab = (const PG8_LAS float*)(lds + MIDK_TAB) + wr * 64 + fr;
#pragma unroll
        for (int ai = 0; ai < 2; ++ai)
#pragma unroll
            for (int m = 0; m < 4; ++m) { const float f = tab[ai * HALF + m * 16];
#pragma unroll
                for (int bj = 0; bj < 2; ++bj)
#pragma unroll
                    for (int n = 0; n < 2; ++n) { const i32x4 iv = __builtin_bit_cast(i32x4, acc[ai][bj][m][n]);
                        const i32x4 o = {(int)__builtin_rintf((float)iv[0] * f), (int)__builtin_rintf((float)iv[1] * f), (int)__builtin_rintf((float)iv[2] * f), (int)__builtin_rintf((float)iv[3] * f)};
                        acc[ai][bj][m][n] = __builtin_bit_cast(f32x4, o); } }
    }
    __device__ __forceinline__ void operator()(const f32x4 (&acc)[2][2][4][2], const Unit& u, int wr, int wc, int fr, int fq) const {
        const int row0 = u.pm * BM + wr * 64 + fr, col0 = u.pn * BM + wc * 32 + 8 * fq;
        f32x4 cs[2][2];
#pragma unroll
        for (int bj = 0; bj < 2; ++bj)
#pragma unroll
            for (int n = 0; n < 2; ++n) cs[bj][n] = *(const f32x4*)(colmax + col0 + bj * HALF + 4 * n) * (1.f / 127.f);
#pragma unroll
        for (int ai = 0; ai < 2; ++ai) {
            u32x4 b[4][2];
#pragma unroll
            for (int m = 0; m < 4; ++m)
#pragma unroll
                for (int bj = 0; bj < 2; ++bj) b[m][bj] = *(const u32x4*)(base + (size_t)(row0 + ai * HALF + m * 16) * ldc + col0 + bj * HALF);
#pragma unroll
            for (int m = 0; m < 4; ++m) { const int row = row0 + ai * HALF + m * 16; const float sc = rowscale[row];
#pragma unroll
                for (int bj = 0; bj < 2; ++bj) { const u32x4 bw = b[m][bj]; const i32x4 i0 = __builtin_bit_cast(i32x4, acc[ai][bj][m][0]), i1 = __builtin_bit_cast(i32x4, acc[ai][bj][m][1]); const f32x4 c0 = cs[bj][0] * sc, c1 = cs[bj][1] * sc;
                    u32x4 w;
                    w.x = cvt_pk_bf16(__uint_as_float(bw.x << 16) + (float)i0[0] * c0[0], __uint_as_float(bw.x & 0xffff0000u) + (float)i0[1] * c0[1]); w.y = cvt_pk_bf16(__uint_as_float(bw.y << 16) + (float)i0[2] * c0[2], __uint_as_float(bw.y & 0xffff0000u) + (float)i0[3] * c0[3]);
                    w.z = cvt_pk_bf16(__uint_as_float(bw.z << 16) + (float)i1[0] * c1[0], __uint_as_float(bw.z & 0xffff0000u) + (float)i1[1] * c1[1]); w.w = cvt_pk_bf16(__uint_as_float(bw.w << 16) + (float)i1[2] * c1[2], __uint_as_float(bw.w & 0xffff0000u) + (float)i1[3] * c1[3]);
                    *(u32x4*)(out + (size_t)row * ldc + col0 + bj * HALF) = w; } }
        }
    }
};
struct EpiResBf16 {
    static constexpr bool PERM = true, AFTER_DRAIN = false;
    static constexpr int MIDK_TAB = 147456 + 8192;
    const bf16_t* base; bf16_t* out; int ldc; float scale;
    const float* rss;
    __device__ __forceinline__ void midk_pre(const Unit& u, PG8_LAS unsigned char* lds, int wid) const {
        unsigned z_ = 0u; asm volatile("" : "+v"(z_)); const int tid = (wid << 6) | (int)__builtin_amdgcn_mbcnt_hi(~0u, __builtin_amdgcn_mbcnt_lo(~0u, z_));
        const int rl = tid >> 1; const f32x4* p = (const f32x4*)(rss + ((size_t)(u.pm * BM + rl) * 16 + (tid & 1) * 8));
        const f32x4 a = p[0], b = p[1]; float s = ((a[0] + a[1]) + (a[2] + a[3])) + ((b[0] + b[1]) + (b[2] + b[3]));
        s += __int_as_float(__builtin_amdgcn_ds_swizzle(__float_as_int(s), 0x041F));
        ((PG8_LAS float*)(lds + MIDK_TAB))[rl] = 1.0f / sqrtf(s * (1.f / 2048.f) + 1e-6f);
    }
    __device__ __forceinline__ void midk(f32x4 (&acc)[2][2][4][2], PG8_LAS unsigned char* lds, int wr, int fr) const {
        const PG8_LAS float* tab = (const PG8_LAS float*)(lds + MIDK_TAB) + wr * 64 + fr;
#pragma unroll
        for (int ai = 0; ai < 2; ++ai)
#pragma unroll
            for (int m = 0; m < 4; ++m) { const float f = tab[ai * HALF + m * 16];
#pragma unroll
                for (int bj = 0; bj < 2; ++bj)
#pragma unroll
                    for (int n = 0; n < 2; ++n) acc[ai][bj][m][n] = acc[ai][bj][m][n] * f; }
    }
    __device__ __forceinline__ void operator()(const f32x4 (&acc)[2][2][4][2], const Unit& u, int wr, int wc, int fr, int fq) const {
        const int row0 = u.pm * BM + wr * 64 + fr, col0 = u.pn * BM + wc * 32 + 8 * fq;
#pragma unroll
        for (int ai = 0; ai < 2; ++ai) {
            u32x4 b[4][2];
#pragma unroll
            for (int m = 0; m < 4; ++m)
#pragma unroll
                for (int bj = 0; bj < 2; ++bj) b[m][bj] = *(const u32x4*)(base + (size_t)(row0 + ai * HALF + m * 16) * ldc + col0 + bj * HALF);
#pragma unroll
            for (int m = 0; m < 4; ++m)
#pragma unroll
                for (int bj = 0; bj < 2; ++bj) { const u32x4 bw = b[m][bj]; const f32x4 v0 = acc[ai][bj][m][0] * scale, v1 = acc[ai][bj][m][1] * scale;
                    u32x4 w;
                    w.x = cvt_pk_bf16(__uint_as_float(bw.x << 16) + v0[0], __uint_as_float(bw.x & 0xffff0000u) + v0[1]); w.y = cvt_pk_bf16(__uint_as_float(bw.y << 16) + v0[2], __uint_as_float(bw.y & 0xffff0000u) + v0[3]);
                    w.z = cvt_pk_bf16(__uint_as_float(bw.z << 16) + v1[0], __uint_as_float(bw.z & 0xffff0000u) + v1[1]); w.w = cvt_pk_bf16(__uint_as_float(bw.w << 16) + v1[2], __uint_as_float(bw.w & 0xffff0000u) + v1[3]);
                    *(u32x4*)(out + (size_t)(row0 + ai * HALF + m * 16) * ldc + col0 + bj * HALF) = w; }
        }
    }
};
template <int NS> struct SideZero {
    static constexpr bool ACTIVE = true;
    unsigned char* slice;
    __device__ __forceinline__ void tick(int k, int tid) const {
        u32x4 z = {0u, 0u, 0u, 0u}; asm volatile("" : "+v"(z));
        unsigned char* p = slice + (size_t)k * (8192 * NS) + tid * 16;
#pragma unroll
        for (int i = 0; i < NS; ++i) *(u32x4*)(p + i * 8192) = z;
    }
};
struct EpiNull {
    static constexpr bool PERM = true, AFTER_DRAIN = false;
    __device__ __forceinline__ void operator()(const f32x4 (&acc)[2][2][4][2], const Unit& u, int wr, int wc, int fr, int fq) const { asm volatile("" :: "v"(acc[0][0][0][0]), "v"(acc[1][1][3][1])); }
};
__device__ __forceinline__ i32x6 pg8_cat6(const i32x4 lo, const i32x2 hi) { const i32x4 h4 = __builtin_shufflevector(hi, hi, 0, 1, -1, -1); return __builtin_shufflevector(lo, h4, 0, 1, 2, 3, 4, 5); }
struct NoSide { static constexpr bool ACTIVE = false; __device__ __forceinline__ void tick(int, int) const {} };
template <class Epi, class Sched, bool ALIGN_EPI = false, bool SP2 = false, int MODE = 0, bool MIDK = false, class Side = NoSide>
__device__ __forceinline__ void gemm_phase(PG8_LAS unsigned char* lds, const Gemm g, const Sched& S, const Epi& E, const int wave_id  , const Side SD = Side()) {
    constexpr bool FP6 = (MODE == 3), FP8 = (MODE == 1) || FP6, I8 = (MODE == 2);
    unsigned z_ = 0u; asm volatile("" : "+v"(z_)); const int tid_ = (wave_id << 6) | (int)__builtin_amdgcn_mbcnt_hi(~0u, __builtin_amdgcn_mbcnt_lo(~0u, z_));
    const int tid = tid_, wid = __builtin_amdgcn_readfirstlane(tid >> 6), lane = tid & 63, wr = wid >> 2, wc = wid & 3, fr = lane & 15, fq = lane >> 4;
    const int K = g.K, nt = K / BK;
    unsigned voffA[2], voffB[2];
#pragma unroll
    for (int i = 0; i < 2; ++i) { int R, C; stage_rc(tid * 16 + i * 8192, R, C); const int Rb = Epi::PERM ? ((R & ~31) + perm32(R & 31)) : R;
        voffA[i] = (unsigned)(R * K + C) * 2u; voffB[i] = (unsigned)(Rb * K + C) * 2u; }
    const size_t kstep = (size_t)(BK * 2);
    const size_t hstep = (size_t)HALF * K * 2;
    const size_t tstep = 2 * hstep;
    const unsigned ldsw = (unsigned)wid * 1024u;
    const int aoff = lds_byte(wr * 64 + fr, fq * 8), boff = lds_byte(wc * 32 + fr, fq * 8);
#define PG8_SA(b, h) (((b) * 2 + (h)) * HTB)
#define PG8_SB(b, h) ((4 + (b) * 2 + (h)) * HTB)
#define PG8_STAGE(bufoff, gbase, voff) do { _Pragma("unroll") for (int _i = 0; _i < 2; ++_i) \
        __builtin_amdgcn_global_load_lds((const unsigned*)((const char*)(gbase) + (voff)[_i]), (PG8_LAS unsigned*)(lds + (bufoff) + ldsw + _i * 8192), 16, 0, 0); } while (0)
#define PG8_CAT(lo, hi) __builtin_shufflevector(lo, hi, 0, 1, 2, 3, 4, 5, 6, 7)
#define PG8_CAT6(lo, hi2) pg8_cat6(lo, hi2)
#define PG8_LDA(dst, b, h) do { if constexpr (FP6) { _Pragma("unroll") for (int m = 0; m < 4; ++m) dst##6[m] = PG8_CAT6(*(const PG8_LAS i32x4*)(lds + PG8_SA(b, h) + aoff + m * 2048), *(const volatile PG8_LAS i32x2*)(lds + PG8_SA(b, h) + aoff + m * 2048 + 1024)); } \
        else if constexpr (FP8) { _Pragma("unroll") for (int m = 0; m < 4; ++m) dst##8[m] = PG8_CAT(*(const PG8_LAS i32x4*)(lds + PG8_SA(b, h) + aoff + m * 2048), *(const PG8_LAS i32x4*)(lds + PG8_SA(b, h) + aoff + m * 2048 + 1024)); } \
        else { _Pragma("unroll") for (int m = 0; m < 4; ++m) _Pragma("unroll") for (int k = 0; k < 2; ++k) dst[m][k] = *(const PG8_LAS bf16x8*)(lds + PG8_SA(b, h) + aoff + m * 2048 + k * 1024); } } while (0)
#define PG8_LDB(dst, b, h) do { if constexpr (FP6) { _Pragma("unroll") for (int n = 0; n < 2; ++n) dst##6[n] = PG8_CAT6(*(const PG8_LAS i32x4*)(lds + PG8_SB(b, h) + boff + n * 2048), *(const volatile PG8_LAS i32x2*)(lds + PG8_SB(b, h) + boff + n * 2048 + 1024)); } \
        else if constexpr (FP8) { _Pragma("unroll") for (int n = 0; n < 2; ++n) dst##8[n] = PG8_CAT(*(const PG8_LAS i32x4*)(lds + PG8_SB(b, h) + boff + n * 2048), *(const PG8_LAS i32x4*)(lds + PG8_SB(b, h) + boff + n * 2048 + 1024)); } \
        else { _Pragma("unroll") for (int n = 0; n < 2; ++n) _Pragma("unroll") for (int k = 0; k < 2; ++k) dst[n][k] = *(const PG8_LAS bf16x8*)(lds + PG8_SB(b, h) + boff + n * 2048 + k * 1024); } } while (0)
#define PG8_MMA(ai, bj, At, Bt) do { __builtin_amdgcn_s_setprio(1); if constexpr (FP8) asm volatile("s_nop 4" ::: "memory"); _Pragma("unroll") for (int m = 0; m < 4; ++m) _Pragma("unroll") for (int n = 0; n < 2; ++n) { \
        if constexpr (FP6) asm volatile("v_mfma_scale_f32_16x16x128_f8f6f4 %0, %1, %2, %0, %3, %3 op_sel_hi:[0,0,0] cbsz:2 blgp:2" : "+v"(acc[ai][bj][m][n]) : "v"(Bt##6[n]), "v"(At##6[m]), "v"(scl1)); \
        else if constexpr (FP8) asm volatile("v_mfma_scale_f32_16x16x128_f8f6f4 %0, %1, %2, %0, %3, %3 op_sel_hi:[0,0,0]" : "+v"(acc[ai][bj][m][n]) : "v"(Bt##8[n]), "v"(At##8[m]), "v"(scl1));   \
        else if constexpr (I8) { _Pragma("unroll") for (int k = 0; k < 2; ++k) acc[ai][bj][m][n] = __builtin_bit_cast(f32x4, __builtin_amdgcn_mfma_i32_16x16x64_i8(__builtin_bit_cast(i32x4, Bt[n][k]), __builtin_bit_cast(i32x4, At[m][k]), __builtin_bit_cast(i32x4, acc[ai][bj][m][n]), 0, 0, 0)); } \
        else { _Pragma("unroll") for (int k = 0; k < 2; ++k) acc[ai][bj][m][n] = __builtin_amdgcn_mfma_f32_16x16x32_bf16(Bt[n][k], At[m][k], acc[ai][bj][m][n], 0, 0, 0); } } __builtin_amdgcn_s_setprio(0); } while (0)
#define PG8_WAIT_V(n) asm volatile("s_waitcnt vmcnt(" #n ")" ::: "memory")
#define PG8_WAIT_L(n) asm volatile("s_waitcnt lgkmcnt(" #n ")" ::: "memory")
#define PG8_BAR __builtin_amdgcn_s_barrier()
#define PG8_SCHED __builtin_amdgcn_sched_barrier(0)
    Unit cur, nxt; int ui = 0;
    if (!S.next(0, cur)) return;
    f32x4 acc[2][2][4][2];
#pragma unroll
    for (int a = 0; a < 2; ++a)
#pragma unroll
        for (int b = 0; b < 2; ++b)
#pragma unroll
            for (int m = 0; m < 4; ++m)
#pragma unroll
                for (int n = 0; n < 2; ++n) acc[a][b][m][n] = (f32x4){0.f, 0.f, 0.f, 0.f};
    bf16x8 At[4][2], B0[2][2], B1[2][2];
    i32x8 At8[4], B08[2], B18[2];
    i32x6 At6[4], B06[2], B16[2];
    int scl1 = 0x7F7F7F7F; asm volatile("" : "+v"(scl1));
    const char* cA = (const char*)g.A + (size_t)cur.pm * tstep; const char* cB = (const char*)g.Bt + (size_t)cur.pn * tstep;
    S.a_ready(cur);
    if constexpr (MIDK) E.midk_pre(cur, lds, wid);
    if constexpr (SP2) {
        PG8_STAGE(PG8_SB(0, 0), cB, voffB); PG8_STAGE(PG8_SB(0, 1), cB + hstep, voffB); PG8_STAGE(PG8_SA(0, 0), cA, voffA); PG8_STAGE(PG8_SA(0, 1), cA + hstep, voffA);
        if (wr == 1) PG8_BAR;
        PG8_WAIT_V(2); PG8_BAR;
        PG8_STAGE(PG8_SB(1, 0), cB + kstep, voffB); PG8_STAGE(PG8_SA(1, 0), cA + kstep, voffA); PG8_STAGE(PG8_SB(1, 1), cB + hstep + kstep, voffB);
        PG8_WAIT_V(6); PG8_BAR;
    } else {
        PG8_STAGE(PG8_SB(0, 0), cB, voffB); PG8_STAGE(PG8_SA(0, 0), cA, voffA); PG8_STAGE(PG8_SB(0, 1), cB + hstep, voffB); PG8_STAGE(PG8_SA(0, 1), cA + hstep, voffA);
        if (wr == 1) PG8_BAR;
        PG8_WAIT_V(4); PG8_BAR;
        PG8_STAGE(PG8_SB(1, 0), cB + kstep, voffB); PG8_STAGE(PG8_SA(1, 0), cA + kstep, voffA); PG8_STAGE(PG8_SB(1, 1), cB + hstep + kstep, voffB);
        PG8_WAIT_V(6); PG8_BAR;
    }
    for (;;) {
        const bool has_next = S.next(ui + 1, nxt);
        const char* nA = has_next ? (const char*)g.A + (size_t)nxt.pm * tstep : cA; const char* nB = has_next ? (const char*)g.Bt + (size_t)nxt.pn * tstep : cB;
        for (int t = 0; t < nt; t += 2) {
            const bool last = (t == nt - 2);
            const char* a1 = cA + (size_t)(t + 1) * kstep;
            const char* a2 = last ? nA : cA + (size_t)(t + 2) * kstep; const char* b2 = last ? nB : cB + (size_t)(t + 2) * kstep;
            const char* a3 = a2 + kstep; const char* b3 = b2 + kstep;
            if (last && has_next) S.a_ready(nxt);
            if constexpr (MIDK) { if (t == (nt >> 1)) E.midk(acc, lds, wr, fr); }
            if constexpr (Side::ACTIVE) SD.tick(ui * (nt >> 1) + (t >> 1), tid);
            if constexpr (SP2) {
            PG8_LDB(B0, 0, 0); PG8_LDB(B1, 0, 1); PG8_SCHED; PG8_LDA(At, 0, 0); PG8_STAGE(PG8_SA(1, 1), a1 + hstep, voffA);
            PG8_WAIT_V(8); PG8_WAIT_L(0); PG8_BAR; PG8_MMA(0, 0, At, B0); PG8_MMA(0, 1, At, B1); PG8_BAR; PG8_SCHED;
            PG8_LDA(At, 0, 1); PG8_STAGE(PG8_SB(0, 0), b2, voffB); PG8_STAGE(PG8_SB(0, 1), b2 + hstep, voffB); PG8_STAGE(PG8_SA(0, 0), a2, voffA);
            PG8_WAIT_V(8); PG8_WAIT_L(0); PG8_BAR; PG8_MMA(1, 0, At, B0); PG8_MMA(1, 1, At, B1); PG8_BAR; PG8_SCHED;
            PG8_LDB(B0, 1, 0); PG8_LDB(B1, 1, 1); PG8_SCHED; PG8_LDA(At, 1, 0); PG8_STAGE(PG8_SA(0, 1), a2 + hstep, voffA);
            PG8_WAIT_V(8); PG8_WAIT_L(0); PG8_BAR; PG8_MMA(0, 0, At, B0); PG8_MMA(0, 1, At, B1); PG8_BAR; PG8_SCHED;
            PG8_LDA(At, 1, 1); PG8_STAGE(PG8_SB(1, 0), b3, voffB); PG8_STAGE(PG8_SB(1, 1), b3 + hstep, voffB); PG8_STAGE(PG8_SA(1, 0), a3, voffA);
            PG8_WAIT_V(8); PG8_WAIT_L(0); PG8_BAR; PG8_MMA(1, 0, At, B0); PG8_MMA(1, 1, At, B1); PG8_BAR; PG8_SCHED;
            } else {
            PG8_LDB(B0, 0, 0); PG8_SCHED; PG8_LDA(At, 0, 0); PG8_STAGE(PG8_SA(1, 1), a1 + hstep, voffA);
            PG8_WAIT_L(8); PG8_BAR; PG8_WAIT_L(0); PG8_MMA(0, 0, At, B0); PG8_BAR; PG8_SCHED;
            PG8_LDB(B1, 0, 1); PG8_STAGE(PG8_SB(0, 0), b2, voffB);
            PG8_BAR; PG8_WAIT_L(0); PG8_MMA(0, 1, At, B1); PG8_BAR;
            PG8_LDA(At, 0, 1); PG8_STAGE(PG8_SA(0, 0), a2, voffA);
            PG8_BAR; PG8_WAIT_L(0); PG8_MMA(1, 0, At, B0); PG8_BAR; PG8_SCHED;
            PG8_STAGE(PG8_SB(0, 1), b2 + hstep, voffB);
            PG8_WAIT_V(6); PG8_BAR; PG8_MMA(1, 1, At, B1); PG8_BAR;
            PG8_LDB(B0, 1, 0); PG8_SCHED; PG8_LDA(At, 1, 0); PG8_STAGE(PG8_SA(0, 1), a2 + hstep, voffA);
            PG8_WAIT_L(8); PG8_BAR; PG8_WAIT_L(0); PG8_MMA(0, 0, At, B0); PG8_BAR; PG8_SCHED;
            PG8_LDB(B1, 1, 1); PG8_STAGE(PG8_SB(1, 0), b3, voffB);
            PG8_BAR; PG8_WAIT_L(0); PG8_MMA(0, 1, At, B1); PG8_BAR;
            PG8_LDA(At, 1, 1); PG8_STAGE(PG8_SA(1, 0), a3, voffA);
            PG8_BAR; PG8_WAIT_L(0); PG8_MMA(1, 0, At, B0); PG8_BAR; PG8_SCHED;
            PG8_STAGE(PG8_SB(1, 1), b3 + hstep, voffB);
            PG8_WAIT_V(6); PG8_BAR; PG8_MMA(1, 1, At, B1); PG8_BAR;
            }
        }
        if constexpr (ALIGN_EPI) { if (wr == 0) PG8_BAR; }
        if constexpr (FP8) asm volatile("s_nop 15\n\ts_nop 15" ::: "memory");
        if constexpr (!Epi::AFTER_DRAIN) { E(acc, cur, wr, wc, fr, fq); S.done(cur); }
        if (!has_next) break;
#pragma unroll
        for (int a = 0; a < 2; ++a)
#pragma unroll
            for (int b = 0; b < 2; ++b)
#pragma unroll
                for (int m = 0; m < 4; ++m)
#pragma unroll
                    for (int n = 0; n < 2; ++n) acc[a][b][m][n] = (f32x4){0.f, 0.f, 0.f, 0.f};
        cur = nxt; cA = nA; cB = nB; ++ui;
        if constexpr (MIDK) E.midk_pre(cur, lds, wid);
        if constexpr (ALIGN_EPI) { if (wr == 1) PG8_BAR; }
    }
    PG8_WAIT_V(0);
    if constexpr (!ALIGN_EPI) { if (wr == 0) PG8_BAR; }
    PG8_BAR;
    if constexpr (Epi::AFTER_DRAIN) { E.fused(acc, cur, wr, wc, fr, fq, lds, wid, lane); S.done(cur); }
#undef PG8_SA
#undef PG8_SB
#undef PG8_STAGE
#undef PG8_LDA
#undef PG8_LDB
#undef PG8_MMA
#undef PG8_CAT
#undef PG8_CAT6
#undef PG8_WAIT_V
#undef PG8_WAIT_L
#undef PG8_BAR
#undef PG8_SCHED
}
}
namespace pg8 {
constexpr int P6_ROWB = 3072, P6_KT = 96, P6_TILE = 256 * P6_KT, P6_BUF = 2 * P6_TILE, P6_NBUF = 3, P6_NT = P6_ROWB / P6_KT, P6_RING = P6_NBUF * P6_BUF;
template <class Epi, class Sched>
__device__ __forceinline__ void gemm_phase_fp6p(PG8_LAS unsigned char* lds, const unsigned char* Ap, const unsigned char* Bp, const Sched& S, const Epi& E, const int wave_id  ) {
    static_assert(!Epi::AFTER_DRAIN, "in-loop epilogues only");
    unsigned z_ = 0u; asm volatile("" : "+v"(z_)); const int tid_ = (wave_id << 6) | (int)__builtin_amdgcn_mbcnt_hi(~0u, __builtin_amdgcn_mbcnt_lo(~0u, z_));
    const int tid = tid_, wid = __builtin_amdgcn_readfirstlane(tid >> 6), lane = tid & 63, wr = wid >> 2, wc = wid & 3, fr = lane & 15, fq = lane >> 4;
    const unsigned voff = (unsigned)(wid * 3 * 64 + lane) * 16u;
    const size_t tstep = (size_t)P6_NT * P6_TILE;
    const unsigned ldsw = (unsigned)wid * 3072u;
    const int cls_l = fr >> 3, p128 = ((fq == 0) ? 0 : (fq == 1) ? 3 : (fq == 2) ? 2 : 5) * 16, p64 = (((fq < 2) != (cls_l != 0)) ? 1 : 4) * 16 + (fq & 1) * 8;
    const int a128 = (wr * 64 + fr) * P6_KT + p128, a64 = (wr * 64 + fr) * P6_KT + p64, b128 = P6_TILE + (wc * 32 + fr) * P6_KT + p128, b64 = P6_TILE + (wc * 32 + fr) * P6_KT + p64;
#define P6_STAGE(tileoff, gbase) do { _Pragma("unroll") for (int _j = 0; _j < 3; ++_j) \
        __builtin_amdgcn_global_load_lds((const unsigned*)((const char*)(gbase) + voff + _j * 1024), (PG8_LAS unsigned*)(lds + (tileoff) + ldsw + _j * 1024), 16, 0, 0); } while (0)
#define P6_LDA(dst, bo, h) do { _Pragma("unroll") for (int m = 0; m < 4; ++m) dst[m] = pg8_cat6(*(const PG8_LAS i32x4*)(lds + (bo) + a128 + (h) * (128 * P6_KT) + m * (16 * P6_KT)), *(const volatile PG8_LAS i32x2*)(lds + (bo) + a64 + (h) * (128 * P6_KT) + m * (16 * P6_KT))); } while (0)
#define P6_LDB(dst, bo, h) do { _Pragma("unroll") for (int n = 0; n < 2; ++n) dst[n] = pg8_cat6(*(const PG8_LAS i32x4*)(lds + (bo) + b128 + (h) * (128 * P6_KT) + n * (16 * P6_KT)), *(const volatile PG8_LAS i32x2*)(lds + (bo) + b64 + (h) * (128 * P6_KT) + n * (16 * P6_KT))); } while (0)
#define P6_MMA(ai, bj, At, Bt) do { __builtin_amdgcn_s_setprio(1); asm volatile("s_nop 4" ::: "memory"); _Pragma("unroll") for (int m = 0; m < 4; ++m) _Pragma("unroll") for (int n = 0; n < 2; ++n) \
        asm volatile("v_mfma_scale_f32_16x16x128_f8f6f4 %0, %1, %2, %0, %3, %3 op_sel_hi:[0,0,0] cbsz:2 blgp:2" : "+v"(acc[ai][bj][m][n]) : "v"(Bt[n]), "v"(At[m]), "v"(scl1)); \
        __builtin_amdgcn_s_setprio(0); } while (0)
#define P6_WAIT_V(n) asm volatile("s_waitcnt vmcnt(" #n ")" ::: "memory")
#define P6_WAIT_L(n) asm volatile("s_waitcnt lgkmcnt(" #n ")" ::: "memory")
#define P6_BAR __builtin_amdgcn_s_barrier()
#define P6_SCHED __builtin_amdgcn_sched_barrier(0)
    Unit cur, nxt; int ui = 0;
    if (!S.next(0, cur)) return;
    f32x4 acc[2][2][4][2];
#pragma unroll
    for (int a = 0; a < 2; ++a)
#pragma unroll
        for (int b = 0; b < 2; ++b)
#pragma unroll
            for (int m = 0; m < 4; ++m)
#pragma unroll
                for (int n = 0; n < 2; ++n) acc[a][b][m][n] = (f32x4){0.f, 0.f, 0.f, 0.f};
    i32x6 At[4], B0[2], B1[2];
    int scl1 = 0x7F7F7F7F; asm volatile("" : "+v"(scl1));
    const char* cA = (const char*)Ap + (size_t)cur.pm * tstep; const char* cB = (const char*)Bp + (size_t)cur.pn * tstep;
    S.a_ready(cur);
    P6_STAGE(P6_TILE, cB); P6_STAGE(0, cA); P6_STAGE(P6_BUF + P6_TILE, cB + P6_TILE); P6_STAGE(P6_BUF, cA + P6_TILE);
    if (wr == 1) P6_BAR;
    P6_WAIT_V(6); P6_BAR;
    P6_BAR;
    int boc = 0, bos = 2 * P6_BUF;
    for (;;) {
        const bool has_next = S.next(ui + 1, nxt);
        const char* nA = has_next ? (const char*)Ap + (size_t)nxt.pm * tstep : cA; const char* nB = has_next ? (const char*)Bp + (size_t)nxt.pn * tstep : cB;
#pragma unroll 1
        for (int t = 0; t < P6_NT; ++t) {
            const bool wrap = (t + 2 >= P6_NT);
            const char* a2 = (wrap ? nA : cA) + (size_t)(wrap ? t + 2 - P6_NT : t + 2) * P6_TILE; const char* b2 = (wrap ? nB : cB) + (size_t)(wrap ? t + 2 - P6_NT : t + 2) * P6_TILE;
            if (t == P6_NT - 2 && has_next) S.a_ready(nxt);
            P6_LDB(B0, boc, 0); P6_LDB(B1, boc, 1); P6_SCHED; P6_LDA(At, boc, 0); P6_STAGE(bos + P6_TILE, b2);
            P6_WAIT_L(0); P6_BAR; P6_MMA(0, 0, At, B0); P6_MMA(0, 1, At, B1); P6_BAR; P6_SCHED;
            P6_LDA(At, boc, 1); P6_STAGE(bos, a2);
            P6_WAIT_V(6); P6_WAIT_L(0); P6_BAR; P6_MMA(1, 0, At, B0); P6_MMA(1, 1, At, B1); P6_BAR; P6_SCHED;
            boc = (boc == 2 * P6_BUF) ? 0 : boc + P6_BUF; bos = (bos == 2 * P6_BUF) ? 0 : bos + P6_BUF;
        }
        if (wr == 0) P6_BAR;
        asm volatile("s_nop 15\n\ts_nop 15" ::: "memory");
        E(acc, cur, wr, wc, fr, fq); S.done(cur);
        if (!has_next) break;
#pragma unroll
        for (int a = 0; a < 2; ++a)
#pragma unroll
            for (int b = 0; b < 2; ++b)
#pragma unroll
                for (int m = 0; m < 4; ++m)
#pragma unroll
                    for (int n = 0; n < 2; ++n) acc[a][b][m][n] = (f32x4){0.f, 0.f, 0.f, 0.f};
        cur = nxt; cA = nA; cB = nB; ++ui;
        if (wr == 1) P6_BAR;
    }
    P6_WAIT_V(0);
    P6_BAR;
#undef P6_STAGE
#undef P6_LDA
#undef P6_LDB
#undef P6_MMA
#undef P6_WAIT_V
#undef P6_WAIT_L
#undef P6_BAR
#undef P6_SCHED
}
}
namespace attn128 {
using bf16 = __hip_bfloat16;
constexpr int   D = 128, NW = 8, QBLK = 32, KVBLK = 64;
constexpr float SCALE = 0.088388347648318440f;
constexpr float THR = 8.f;
constexpr int SDEPTH = 2;
constexpr int LDQ = 9216, LDK = 9216, LDO = 4096;
constexpr int NBUF = 3;
constexpr size_t SHM_V = KVBLK * D * 2, SHM_K = KVBLK * D * 2, SHM_ATTN = NBUF * SHM_V + NBUF * SHM_K + NW * 64 * 4;
using bf16x8 = __attribute__((ext_vector_type(8))) short;
using s16x4  = __attribute__((ext_vector_type(4))) short;
using f32x16 = __attribute__((ext_vector_type(16))) float;
using f32x8  = __attribute__((ext_vector_type(8))) float;
using u32x4  = __attribute__((ext_vector_type(4))) unsigned;
#define KSWZ(row, colB) ((row) * 256 + ((colB) ^ (((row) & 7) << 4)))
#define SBAR() __builtin_amdgcn_sched_barrier(0)
__device__ __forceinline__ int crow(int r, int hi) { return (r & 3) + 8 * (r >> 2) + 4 * hi; }
__device__ __forceinline__ unsigned cvtpk(float lo, float hi) {
  unsigned r; asm volatile("v_cvt_pk_bf16_f32 %0, %1, %2" : "=v"(r) : "v"(lo), "v"(hi)); return r;
}
template <typename TIn> struct Stage;
template <> struct Stage<bf16>  { using T = bf16x8;
  __device__ static __forceinline__ T ld8(const bf16* p) { return *reinterpret_cast<const bf16x8*>(p); }
  __device__ static __forceinline__ bf16x8 tobf(T x) { return x; } };
template <> struct Stage<float> { using T = f32x8;
  __device__ static __forceinline__ T ld8(const float* p) { return *reinterpret_cast<const f32x8*>(p); }
  __device__ static __forceinline__ bf16x8 tobf(T x) {
    u32x4 w = {cvtpk(x[0], x[1]), cvtpk(x[2], x[3]), cvtpk(x[4], x[5]), cvtpk(x[6], x[7])}; return *reinterpret_cast<bf16x8*>(&w); } };

template <bool NOSHIFT> __device__ __forceinline__ void partialSM(f32x16& p0, f32x16& p1, float& m_reg, float& mn, float& alpha) {
  constexpr float C = SCALE * 1.4426950408889634f;
  if constexpr (NOSHIFT) { mn = 0.f; alpha = 1.f; for (int r = 0; r < 16; ++r) p0[r] = __builtin_amdgcn_exp2f(p0[r]); return; }
  float pmax = p0[0]; for (int r = 1; r < 16; ++r) pmax = fmaxf(pmax, p0[r]); for (int r = 0; r < 16; ++r) pmax = fmaxf(pmax, p1[r]);
  { auto rr = __builtin_amdgcn_permlane32_swap(__float_as_uint(pmax), __float_as_uint(pmax), false, false);
    pmax = fmaxf(__uint_as_float(rr[0]), __uint_as_float(rr[1])); }
  if (__builtin_expect(__all(pmax - m_reg <= THR / SCALE), 1)) { mn = m_reg; alpha = 1.f; }
  else { mn = fmaxf(m_reg, pmax); alpha = __builtin_amdgcn_exp2f((m_reg - mn) * C); m_reg = mn; }
  float mnC = -mn * C;
  for (int r = 0; r < 16; ++r) p0[r] = fmaf(p0[r], C, mnC); for (int r = 0; r < 16; ++r) p1[r] = fmaf(p1[r], C, mnC);
  for (int r = 0; r < 16; ++r) p0[r] = __builtin_amdgcn_exp2f(p0[r]);
}
__device__ __forceinline__ void finishSM(f32x16& p0, f32x16& p1, float alpha, float& l_reg, bf16x8& pa0, bf16x8& pa1, bf16x8& pa2, bf16x8& pa3) {
  for (int r = 0; r < 16; ++r) p1[r] = __builtin_amdgcn_exp2f(p1[r]);
  float ps = 0; for (int r = 0; r < 16; ++r) ps += p0[r]; for (int r = 0; r < 16; ++r) ps += p1[r];
  { auto rr = __builtin_amdgcn_permlane32_swap(__float_as_uint(ps), __float_as_uint(ps), false, false);
    ps = __uint_as_float(rr[0]) + __uint_as_float(rr[1]); }
  l_reg = l_reg * alpha + ps;
#define PK4(P, BASE, OUT) do { unsigned a0 = cvtpk(P[BASE + 0], P[BASE + 1]), a1 = cvtpk(P[BASE + 2], P[BASE + 3]);   \
    unsigned b0 = cvtpk(P[BASE + 4], P[BASE + 5]), b1 = cvtpk(P[BASE + 6], P[BASE + 7]);                              \
    auto r0 = __builtin_amdgcn_permlane32_swap(a0, b0, false, false); auto r1 = __builtin_amdgcn_permlane32_swap(a1, b1, false, false); \
    u32x4 w = {r0[0], r1[0], r0[1], r1[1]}; OUT = *reinterpret_cast<bf16x8*>(&w); } while (0)
  PK4(p0, 0, pa0); PK4(p0, 8, pa1); PK4(p1, 0, pa2); PK4(p1, 8, pa3);
#undef PK4
}
__device__ __forceinline__ void qkt(f32x16& p0, f32x16& p1, const bf16* Ks, const bf16x8* qr, int r32, int hi) {
  p0 = f32x16{}; p1 = f32x16{};
  for (int d0 = 0; d0 < 8; ++d0) { int cb = (d0 * 16 + hi * 8) * 2;
    bf16x8 b0 = *reinterpret_cast<const bf16x8*>((const char*)Ks + KSWZ(r32, cb));
    bf16x8 b1 = *reinterpret_cast<const bf16x8*>((const char*)Ks + KSWZ(32 + r32, cb));
    p0 = __builtin_amdgcn_mfma_f32_32x32x16_bf16(b0, qr[d0], p0, 0, 0, 0);
    p1 = __builtin_amdgcn_mfma_f32_32x32x16_bf16(b1, qr[d0], p1, 0, 0, 0); }
}
#define K8SWZ(row, c) ((row) * 128 + ((((c) ^ (((row) >> 1) & 7))) << 4))
using i32x4v = __attribute__((ext_vector_type(4))) int;
using i32x16v = __attribute__((ext_vector_type(16))) int;
__device__ __forceinline__ void qkt_i8(f32x16& p0, f32x16& p1, const char* Ks, const i32x4v* qi, int r32, int hi, float dq) {
  i32x16v a0 = {}, a1 = {};
#pragma unroll
  for (int s4 = 0; s4 < 4; ++s4) {
    const i32x4v b0 = *reinterpret_cast<const i32x4v*>(Ks + K8SWZ(r32, 2 * s4 + hi));
    const i32x4v b1 = *reinterpret_cast<const i32x4v*>(Ks + K8SWZ(32 + r32, 2 * s4 + hi));
    a0 = __builtin_amdgcn_mfma_i32_32x32x32_i8(b0, qi[s4], a0, 0, 0, 0);
    a1 = __builtin_amdgcn_mfma_i32_32x32x32_i8(b1, qi[s4], a1, 0, 0, 0); }
#pragma unroll
  for (int r = 0; r < 16; ++r) { p0[r] = (float)a0[r] * dq; p1[r] = (float)a1[r] * dq; }
}
__device__ __forceinline__ unsigned pk4_i8_rn(float a, float b, float c, float d) {
  const int ia = (int)__builtin_rintf(a), ib = (int)__builtin_rintf(b), ic = (int)__builtin_rintf(c), id = (int)__builtin_rintf(d);
  return (unsigned)(ia & 0xff) | ((unsigned)(ib & 0xff) << 8) | ((unsigned)(ic & 0xff) << 16) | ((unsigned)id << 24);
}
__device__ __forceinline__ int v_st(int k, int c) { const int kk = (k & ~0xC) | ((k & 4) << 1) | ((k & 8) >> 1); return ((kk >> 3) * 4 + (c >> 5)) * 512 + ((kk & 7) * 32 + (c & 31)) * 2; }
__device__ __forceinline__ int v_rd_base(int lane) { return ((lane & 3) << 3) | (((lane >> 2) & 3) << 6) | (((lane >> 4) & 1) << 5) | (((lane >> 5) & 1) << 8); }
constexpr int v_rd_off(int d0, int ks, int half) { return d0 * 512 + ks * 4096 + half * 2048; }
template <int OFF> __device__ __forceinline__ s16x4 tr_read(int vb) {
  s16x4 r; asm volatile("ds_read_b64_tr_b16 %0, %1 offset:%2" : "=&v"(r) : "v"(vb), "i"(OFF) : "memory"); return r;
}
template <int D0> __device__ __forceinline__ void pv_one(f32x16& od, int vb, bf16x8 pa0, bf16x8 pa1, bf16x8 pa2, bf16x8 pa3) {
  const s16x4 l0 = tr_read<v_rd_off(D0, 0, 0)>(vb), h0 = tr_read<v_rd_off(D0, 0, 1)>(vb), l1 = tr_read<v_rd_off(D0, 1, 0)>(vb), h1 = tr_read<v_rd_off(D0, 1, 1)>(vb);
  const s16x4 l2 = tr_read<v_rd_off(D0, 2, 0)>(vb), h2 = tr_read<v_rd_off(D0, 2, 1)>(vb), l3 = tr_read<v_rd_off(D0, 3, 0)>(vb), h3 = tr_read<v_rd_off(D0, 3, 1)>(vb);
  asm volatile("s_waitcnt lgkmcnt(0)" ::: "memory"); SBAR();
#define PK(L, H) (bf16x8){L[0], L[1], L[2], L[3], H[0], H[1], H[2], H[3]}
  od = __builtin_amdgcn_mfma_f32_32x32x16_bf16(pa0, PK(l0, h0), od, 0, 0, 0);
  od = __builtin_amdgcn_mfma_f32_32x32x16_bf16(pa1, PK(l1, h1), od, 0, 0, 0);
  od = __builtin_amdgcn_mfma_f32_32x32x16_bf16(pa2, PK(l2, h2), od, 0, 0, 0);
  od = __builtin_amdgcn_mfma_f32_32x32x16_bf16(pa3, PK(l3, h3), od, 0, 0, 0);
#undef PK
}
__device__ __forceinline__ void pv_d0(f32x16* o, int vb, bf16x8 pa0, bf16x8 pa1, bf16x8 pa2, bf16x8 pa3) {
  pv_one<0>(o[0], vb, pa0, pa1, pa2, pa3); pv_one<1>(o[1], vb, pa0, pa1, pa2, pa3); pv_one<2>(o[2], vb, pa0, pa1, pa2, pa3); pv_one<3>(o[3], vb, pa0, pa1, pa2, pa3);
}

template <typename TQ, bool NOSHIFT, bool QRAW, bool KI8 = false>
__device__ __forceinline__ void attn_dense_body(const TQ* __restrict__ Qb, const bf16* __restrict__ Kh, const bf16* __restrict__ Vh,
                                                bf16* __restrict__ Ob, int seq, char* lds, const int wave_id, const float* __restrict__ qg, const int spos0, const float k_inv_scale = 1.f) {
  using St = Stage<bf16>; using SQ = Stage<TQ>;
  unsigned z_ = 0u; asm volatile("" : "+v"(z_)); const int tid_ = (wave_id << 6) | (int)__builtin_amdgcn_mbcnt_hi(~0u, __builtin_amdgcn_mbcnt_lo(~0u, z_));
  const int tid = tid_, wid = tid >> 6, lane = tid & 63, r32 = lane & 31, hi = lane >> 5;
  bf16* V_lds = (bf16*)lds; bf16* K_lds = (bf16*)(lds + NBUF * SHM_V);
  float* ws = (float*)(lds + NBUF * SHM_V + NBUF * SHM_K) + wid * 64; float* li_l = ws; float* al_l = ws + 32;
  float m_reg = -1e30f, l_reg = 0; f32x16 o[4] = {}; bf16x8 qr[8]; i32x4v qi[4]; float dq = 1.f;
  const TQ* Qw = Qb + (long)(wid * QBLK + r32) * LDQ + hi * 8;
  if constexpr (QRAW) {
    float q[8][8]; float ss = 0.f;
#pragma unroll
    for (int d0 = 0; d0 < 8; ++d0) { const bf16x8 raw = SQ::tobf(SQ::ld8(Qw + d0 * 16)); const u32x4 w = *reinterpret_cast<const u32x4*>(&raw);
#pragma unroll
      for (int e = 0; e < 4; ++e) { q[d0][2 * e] = __uint_as_float(w[e] << 16); q[d0][2 * e + 1] = __uint_as_float(w[e] & 0xffff0000u); }
#pragma unroll
      for (int e = 0; e < 8; ++e) ss += q[d0][e] * q[d0][e]; }
    { auto rr = __builtin_amdgcn_permlane32_swap(__float_as_uint(ss), __float_as_uint(ss), false, false); ss = __uint_as_float(rr[0]) + __uint_as_float(rr[1]); }
    const float rstd = 1.0f / sqrtf(ss * (1.0f / 128.0f) + 1e-6f);
#pragma unroll
    for (int d0 = 0; d0 < 8; ++d0) { const float* gp = qg + d0 * 16 + hi * 8; const float4 g0 = *reinterpret_cast<const float4*>(gp), g1 = *reinterpret_cast<const float4*>(gp + 4);
      q[d0][0] *= rstd * g0.x; q[d0][1] *= rstd * g0.y; q[d0][2] *= rstd * g0.z; q[d0][3] *= rstd * g0.w; q[d0][4] *= rstd * g1.x; q[d0][5] *= rstd * g1.y; q[d0][6] *= rstd * g1.z; q[d0][7] *= rstd * g1.w; }
    const int spos = spos0 + wid * QBLK + r32;
#pragma unroll
    for (int hf = 0; hf < 2; ++hf) { const float pos = (float)(hf ? (spos & 63) : (spos >> 6));
#pragma unroll
      for (int aa = 0; aa < 2; ++aa)
#pragma unroll
        for (int e = 0; e < 8; ++e) { const float inv = exp2f(-(float)(16 * aa + 8 * hi + e) * (13.287712379549449f / 32.0f));
          float rev = pos * inv * 0.15915494309189535f; rev = rev - floorf(rev);
          const float cs = __builtin_amdgcn_cosf(rev), sn = __builtin_amdgcn_sinf(rev);
          const float x1 = q[4 * hf + aa][e], x2 = q[4 * hf + aa + 2][e];
          q[4 * hf + aa][e] = x1 * cs - x2 * sn; q[4 * hf + aa + 2][e] = x1 * sn + x2 * cs; } }
    constexpr float CQ = NOSHIFT ? SCALE * 1.4426950408889634f : 1.0f;
    if constexpr (KI8) {
      float mxq = 0.f;
#pragma unroll
      for (int d0 = 0; d0 < 8; ++d0)
#pragma unroll
        for (int e = 0; e < 8; ++e) mxq = fmaxf(mxq, fabsf(q[d0][e]));
      { auto rr = __builtin_amdgcn_permlane32_swap(__float_as_uint(mxq), __float_as_uint(mxq), false, false); mxq = fmaxf(__uint_as_float(rr[0]), __uint_as_float(rr[1])); }
      const float sq = mxq > 0.f ? 127.f / mxq : 0.f;
      dq = mxq * (1.f / 127.f) * k_inv_scale * CQ;
      unsigned w8[8][2];
#pragma unroll
      for (int d0 = 0; d0 < 8; ++d0) { w8[d0][0] = pk4_i8_rn(q[d0][0] * sq, q[d0][1] * sq, q[d0][2] * sq, q[d0][3] * sq); w8[d0][1] = pk4_i8_rn(q[d0][4] * sq, q[d0][5] * sq, q[d0][6] * sq, q[d0][7] * sq); }
#pragma unroll
      for (int s4 = 0; s4 < 4; ++s4) {
        auto x0 = __builtin_amdgcn_permlane32_swap(w8[2 * s4][0], w8[2 * s4 + 1][0], false, false); auto x1 = __builtin_amdgcn_permlane32_swap(w8[2 * s4][1], w8[2 * s4 + 1][1], false, false);
        qi[s4] = (i32x4v){(int)x0[0], (int)x1[0], (int)x0[1], (int)x1[1]}; }
    } else {
#pragma unroll
    for (int d0 = 0; d0 < 8; ++d0) { u32x4 w;
#pragma unroll
      for (int e = 0; e < 4; ++e) w[e] = cvtpk(q[d0][2 * e] * CQ, q[d0][2 * e + 1] * CQ);
      qr[d0] = *reinterpret_cast<bf16x8*>(&w); }
    }
  } else {
#pragma unroll
  for (int d0 = 0; d0 < 8; ++d0) { qr[d0] = SQ::tobf(SQ::ld8(Qw + d0 * 16));
    if constexpr (NOSHIFT) { constexpr float C = SCALE * 1.4426950408889634f; u32x4 w = *reinterpret_cast<u32x4*>(&qr[d0]);
      for (int e = 0; e < 4; ++e) w[e] = cvtpk(__uint_as_float(w[e] << 16) * C, __uint_as_float(w[e] & 0xffff0000u) * C);
      qr[d0] = *reinterpret_cast<bf16x8*>(&w); } }
  }
  const unsigned lds0 = (unsigned)(uintptr_t)lds;
  long koff[2], voff[2];
#pragma unroll
  for (int i = 0; i < 2; ++i) { const int ci = 2 * wid + i;
    if constexpr (KI8) { const int pch = 64 * wid + lane, r = pch >> 3, c = (pch & 7) ^ ((r >> 1) & 7); koff[i] = (long)r * 128 + c * 16; }
    else { const int r = 4 * ci + (lane >> 4), q = lane & 15, c = q ^ (r & 7); koff[i] = ((long)r * LDK + c * 8) * 2; }
    { const int p = 64 * ci + lane, sb = p >> 5, jj = p & 31, kk = (sb >> 2) * 8 + (jj >> 2), k = (kk & ~0xC) | ((kk & 4) << 1) | ((kk & 8) >> 1), c = (sb & 3) * 32 + (jj & 3) * 8;
      voff[i] = ((long)k * LDK + c) * 2; } }
  const int vb0 = (int)(uintptr_t)V_lds + v_rd_base(lane);
#define GLDS16(gsrc, ldsdst) do { unsigned keep_; asm volatile("s_mov_b32 %0, m0\n\ts_mov_b32 m0, %2\n\ts_nop 0\n\tglobal_load_lds_dwordx4 %1, off\n\ts_mov_b32 m0, %0" : "=&s"(keep_) : "v"(gsrc), "s"(ldsdst) : "memory"); } while (0)
#define DMA_TILE(t, bo) do { const char* kt_ = KI8 ? (const char*)Kh + (long)(t) * KVBLK * 128 : (const char*)Kh + (long)(t) * KVBLK * LDK * 2; const char* vt_ = (const char*)Vh + (long)(t) * KVBLK * LDK * 2; \
    const unsigned kd_ = (unsigned)__builtin_amdgcn_readfirstlane((int)(lds0 + NBUF * SHM_V + (bo) + wid * (KI8 ? 1024 : 2048))), vd_ = (unsigned)__builtin_amdgcn_readfirstlane((int)(lds0 + (bo) + wid * 2048)); \
    GLDS16(kt_ + koff[0], kd_); if constexpr (!KI8) GLDS16(kt_ + koff[1], kd_ + 1024u); GLDS16(vt_ + voff[0], vd_); GLDS16(vt_ + voff[1], vd_ + 1024u); } while (0)
#define QKT(P0, P1, KS) do { if constexpr (KI8) qkt_i8(P0, P1, KS, qi, r32, hi, dq); else qkt(P0, P1, (const bf16*)(KS), qr, r32, hi); } while (0)
#define WAIT_BAR() asm volatile("s_waitcnt vmcnt(0) lgkmcnt(0)\n\ts_barrier" ::: "memory")
#define RESC(a) do { if (__any((a) < 1.f)) { if (hi == 0) al_l[r32] = (a); asm volatile("s_waitcnt lgkmcnt(0)" ::: "memory"); \
    for (int d = 0; d < 4; ++d) for (int r = 0; r < 16; ++r) o[d][r] *= al_l[crow(r, hi)]; } } while (0)
  f32x16 pA0, pA1, pB0, pB1; float mnA, mnB, alA, alB; bf16x8 pa0, pa1, pa2, pa3; const int NT = seq / KVBLK;
  constexpr int SE = 0, SO = SDEPTH - 1;
  DMA_TILE(0, 0); DMA_TILE(1, (int)SHM_V); WAIT_BAR();
  QKT(pA0, pA1, (const char*)K_lds); partialSM<NOSHIFT>(pA0, pA1, m_reg, mnA, alA);
  int bo_prev = 0, bo_cur = (int)SHM_V, bo_next = 2 * (int)SHM_V;
#define ROT() do { bo_prev = bo_cur; bo_cur = bo_next; bo_next = (bo_next == (NBUF - 1) * (int)SHM_V) ? 0 : bo_next + (int)SHM_V; } while (0)
  for (int j = 1; j + 1 < NT; j += 2) {
    DMA_TILE(j + 1, bo_next);
    SBAR(); QKT(pB0, pB1, (const char*)K_lds + bo_cur);
    finishSM(pA0, pA1, alA, l_reg, pa0, pa1, pa2, pa3); SBAR();
    pv_d0(o, vb0 + bo_prev, pa0, pa1, pa2, pa3); partialSM<NOSHIFT>(pB0, pB1, m_reg, mnB, alB);
    RESC(alB); WAIT_BAR(); ROT();
    if (j + 2 < NT) DMA_TILE(j + 2, bo_next);
    SBAR(); QKT(pA0, pA1, (const char*)K_lds + bo_cur);
    finishSM(pB0, pB1, alB, l_reg, pa0, pa1, pa2, pa3); SBAR();
    pv_d0(o, vb0 + bo_prev, pa0, pa1, pa2, pa3); partialSM<NOSHIFT>(pA0, pA1, m_reg, mnA, alA);
    RESC(alA); WAIT_BAR(); ROT();
  }
  SBAR(); QKT(pB0, pB1, (const char*)K_lds + bo_cur);
  finishSM(pA0, pA1, alA, l_reg, pa0, pa1, pa2, pa3); SBAR();
  pv_d0(o, vb0 + bo_prev, pa0, pa1, pa2, pa3); partialSM<NOSHIFT>(pB0, pB1, m_reg, mnB, alB);
  RESC(alB);
  finishSM(pB0, pB1, alB, l_reg, pa0, pa1, pa2, pa3); SBAR();
  pv_d0(o, vb0 + bo_cur, pa0, pa1, pa2, pa3);
#undef ROT
  if (hi == 0) li_l[r32] = l_reg; asm volatile("s_waitcnt lgkmcnt(0)" ::: "memory");
  float rli[16];
  unsigned ze_ = 0u; asm volatile("" : "+v"(ze_)); const int lane_e = (int)__builtin_amdgcn_mbcnt_hi(~0u, __builtin_amdgcn_mbcnt_lo(~0u, ze_)), hi_e = lane_e >> 5, r32_e = lane_e & 31;
#pragma unroll
  for (int r = 0; r < 16; ++r) rli[r] = __builtin_amdgcn_rcpf(li_l[crow(r, hi_e)]);
  bf16* Ow = Ob + (long)(wid * QBLK) * LDO;
#pragma unroll
  for (int r = 0; r < 16; ++r) { int orow = crow(r, hi_e);
    for (int d0 = 0; d0 < 4; ++d0) Ow[(long)orow * LDO + d0 * 32 + r32_e] = __float2bfloat16(o[d0][r] * rli[r]); }
  asm volatile("s_waitcnt vmcnt(0) lgkmcnt(0)\n\ts_barrier" ::: "memory");
#undef GLDS16
#undef QKT
#undef DMA_TILE
#undef WAIT_BAR
#undef RESC
}

#undef KSWZ
#undef K8SWZ
#undef SBAR
}
constexpr int NWAVES = 8;
constexpr int BATCH = 2, SEQ = 8192, DM = 4096, M = BATCH * SEQ;
constexpr int HD = 128, ATTN_W = 2048, CONV_W = 2048, NQH = 16, NKVH = 4, KV_W = 512;
constexpr int IN_COLS = 9216;
constexpr int C_Q = 0, C_K = 2048, C_V = 2560, C_CX = 3072, C_GB = 5120, C_GC = 7168;
constexpr int GRID_W = 64;
constexpr int NKEYS = 128, NEXP = 16384, PHEADS = 8, PTOPK = 16, PQ = 2048;
constexpr float EPS = 1e-6f;

constexpr size_t MiB = 1u << 20;
constexpr size_t WS_CTL = 0, CTL_ZERO_BYTES = 1 * MiB;
constexpr size_t WS_WD8  = 1 * MiB;
constexpr size_t WS_H    = 65 * MiB;
constexpr size_t WS_H8   = 193 * MiB;
constexpr size_t WS_QB   = 65 * MiB, WS_KB = 129 * MiB, WS_VB = 145 * MiB;
constexpr size_t WS_XB   = 129 * MiB;
constexpr size_t WS_X2B  = 545 * MiB;
constexpr size_t WS_G8   = 257 * MiB;
constexpr size_t WS_PROJ = 257 * MiB;
constexpr size_t WS_Y    = 545 * MiB;
constexpr size_t WS_WIN  = 673 * MiB;
constexpr size_t WS_WSC  = 745 * MiB;
constexpr size_t WS_RSS  = 761 * MiB;
constexpr size_t WS_SC   = 769 * MiB;
constexpr size_t WS_WUP8 = 929 * MiB;
constexpr size_t WS_WOUT = 897 * MiB;
constexpr size_t WS_END  = 993 * MiB;
constexpr float H6_SCALE = 1.9f, W6_SCALE = 64.f * 1.9f;
constexpr float WD_SCALE = 64.f, G_SCALE = 32.f;
static_assert(WS_H8 + 64 * MiB <= WS_G8 && WS_G8 + 256 * MiB <= WS_SC, "d_ws map");
constexpr int CW_TMO = 0, CW_CODE = 1, CW_WMAX = 64, CW_XTK = 1024  , CW_BAR = 4096;

constexpr int RING_OFF = 0, RING_BYTES = 147456;
constexpr int LDSCTL_OFF = RING_BYTES, MISC_OFF = LDSCTL_OFF + 320;
constexpr int TK_OFF = LDSCTL_OFF + 512;
constexpr int LDS_BYTES = 163840;
constexpr int H6_ROWB = 3072;
static_assert(LDSCTL_OFF + 8192 + 1024 <= LDS_BYTES, "mid-K factor table");
static_assert(TK_OFF + NWAVES * 512 <= LDS_BYTES, "LDS map");

#define GAS __attribute__((address_space(1)))
#define LAS __attribute__((address_space(3)))
typedef unsigned short bf16;
typedef unsigned v4u __attribute__((ext_vector_type(4)));
typedef float f32x4 __attribute__((ext_vector_type(4)));
typedef short bf16x8 __attribute__((ext_vector_type(8)));
typedef GAS unsigned gu32;
typedef GAS unsigned long long gu64;
#define RLX_AGENT __ATOMIC_RELAXED, __HIP_MEMORY_SCOPE_AGENT
#define LDS_WAIT() asm volatile("s_waitcnt lgkmcnt(0)" ::: "memory")
#define VM_WAIT() asm volatile("s_waitcnt vmcnt(0)" ::: "memory")
__device__ __forceinline__ unsigned long long rt() { return __builtin_amdgcn_s_memrealtime(); }
__device__ __forceinline__ unsigned f2bf(float f) { unsigned u = __builtin_bit_cast(unsigned, f); return (u + 0x7fffu + ((u >> 16) & 1u)) >> 16; }
__device__ __forceinline__ unsigned pk2(float lo, float hi) { return f2bf(lo) | (f2bf(hi) << 16); }

#define XB_TMO      128
#define XB_XCNT(j)  (256  + 64 * (j))
#define XB_XSUB(j)  (1280 + 64 * (j))
#define XB_XGEN(j)  (2304 + 64 * (j))
#define XB_TOP      3328
#define XB_TOPGEN   3392
#define XCD_BAR_WORDS 3456
#define XB_SPIN_CAP (1u << 18)

__device__ __forceinline__ unsigned xb_ld(unsigned* p)              { return __hip_atomic_load(p, __ATOMIC_RELAXED, __HIP_MEMORY_SCOPE_AGENT); }
__device__ __forceinline__ unsigned xb_add(unsigned* p, unsigned v) { return __hip_atomic_fetch_add(p, v, __ATOMIC_RELAXED, __HIP_MEMORY_SCOPE_AGENT); }
__device__ __forceinline__ unsigned xb_xcc_id() { return (unsigned)__builtin_amdgcn_s_getreg((3 << 11) | 20) & 0xFu; }
#define XB_SPIN(cond, bar) do { unsigned _sp = 0; while (cond) { __builtin_amdgcn_s_sleep(1); \
    if ((++_sp & 255u) == 0u) { if (xb_ld(&(bar)[XB_TMO])) break; if (_sp > XB_SPIN_CAP) { atomicAdd(&(bar)[XB_TMO], 1u); break; } } } } while (0)

struct XcdBarrier {
    unsigned* bar; unsigned x;
    volatile LAS unsigned* st;
};

__device__ __forceinline__ XcdBarrier xcd_barrier_post(unsigned* bar, volatile LAS unsigned* st) {
    XcdBarrier b; b.bar = bar; b.x = xb_xcc_id(); b.st = st;
    if (threadIdx.x == 0) (void)xb_add(&bar[XB_XCNT(b.x)], 1u);
    return b;
}
__device__ __forceinline__ void xcd_barrier_complete(unsigned* bar, unsigned x, unsigned& nloc, unsigned& nx) {
    const unsigned G = gridDim.x * gridDim.y * gridDim.z;
    unsigned sum, cnt, mine, sp = 0u;
    for (;;) {
        sum = 0u; cnt = 0u; mine = 0u;
#pragma unroll
        for (unsigned j = 0; j < 16; ++j) { const unsigned c = xb_ld(&bar[XB_XCNT(j)]); sum += c; cnt += (c > 0u) ? 1u : 0u; mine = (j == x) ? c : mine; }
        if (sum == G) break;
        __builtin_amdgcn_s_sleep(1);
        if ((++sp & 255u) == 0u) { if (xb_ld(&bar[XB_TMO])) break; if (sp > XB_SPIN_CAP) { atomicAdd(&bar[XB_TMO], 1u); break; } }
    }
    nloc = mine > 0u ? mine : 1u; nx = cnt > 0u ? cnt : 1u;
}

__device__ __forceinline__ void xcd_barrier(const XcdBarrier& b) {
    asm volatile("s_waitcnt vmcnt(0)" ::: "memory");
    __syncthreads();
    if (threadIdx.x == 0) {
        unsigned* bar = b.bar;
        __builtin_amdgcn_s_waitcnt(0);
        unsigned nloc = b.st[0], nx = b.st[1];
        if (nloc == 0u) { xcd_barrier_complete(bar, b.x, nloc, nx); b.st[0] = nloc; b.st[1] = nx; }
        const unsigned old = xb_add(&bar[XB_XSUB(b.x)], 1u);
        const unsigned gen = old / nloc;
        if (old + 1u == (gen + 1u) * nloc) {
            __builtin_amdgcn_fence(__ATOMIC_RELEASE, "agent");
            asm volatile("s_waitcnt vmcnt(0)" ::: "memory");
            const unsigned og = xb_add(&bar[XB_TOP], 1u);
            const unsigned tg = og / nx;
            if (og + 1u == (tg + 1u) * nx) xb_add(&bar[XB_TOPGEN], 1u);
            else XB_SPIN(xb_ld(&bar[XB_TOPGEN]) == tg, bar);
            __builtin_amdgcn_fence(__ATOMIC_ACQUIRE, "agent");
            xb_add(&bar[XB_XGEN(b.x)], 1u);
            asm volatile("s_waitcnt vmcnt(0)" ::: "memory");
        } else {
            XB_SPIN(xb_ld(&bar[XB_XGEN(b.x)]) == gen, bar);
            __builtin_amdgcn_fence(__ATOMIC_ACQUIRE, "agent");
            asm volatile("s_waitcnt vmcnt(0)" ::: "memory");
        }
    }
    __syncthreads();
}

struct Frame {
    LAS unsigned char* lds;
    volatile LAS unsigned* MISC;
    int tid, lane, wave;
    int vcu, G, cid;
};
struct Args { const float* in[15]; float* out; unsigned char* ws; int nphase; int pad; };
typedef __attribute__((address_space(4))) const unsigned char* kargp_t;
__device__ __forceinline__ kargp_t kargs() { kargp_t p = (kargp_t)__builtin_amdgcn_kernarg_segment_ptr(); asm volatile("" : "+s"(p)); return p; }
typedef const float* cfp_t; typedef float* fp_t; typedef unsigned char* ucp_t;
#define CAS4 __attribute__((address_space(4)))
__device__ __forceinline__ const float* kin(int i) { return *(const CAS4 cfp_t*)(kargs() + 8 * i); }
__device__ __forceinline__ float* kout() { return *(const CAS4 fp_t*)(kargs() + 120); }
__device__ __forceinline__ unsigned char* kws() { return *(const CAS4 ucp_t*)(kargs() + 128); }
static_assert(sizeof(Args) == 144, "Args layout");
#define T_x()            kin(0)
#define T_norm_mix_g()   kin(1)
#define T_w_in()         kin(2)
#define T_q_norm_g()     kin(3)
#define T_k_norm_g()     kin(4)
#define T_conv_w()       kin(5)
#define T_attn_out_g()   kin(6)
#define T_conv_out_g()   kin(7)
#define T_w_out()        kin(8)
#define T_norm_ffn_g()   kin(9)
#define T_w_query()      kin(10)
#define T_sub_keys()     kin(11)
#define T_w_down()       kin(12)
#define T_w_up()         kin(13)
#define T_norm_final_g() kin(14)
#define T_WD8()  ((unsigned char*)(kws() + WS_WD8))
#define T_H8()   ((unsigned char*)(kws() + WS_H8))
#define T_H()    ((bf16*)(kws() + WS_H))
#define T_G8()   ((unsigned char*)(kws() + WS_G8))
#define T_PROJ() ((bf16*)(kws() + WS_PROJ))
#define T_Y()    ((bf16*)(kws() + WS_Y))
#define T_WIN8() ((unsigned char*)(kws() + WS_WIN))
#define T_HI8()  ((unsigned char*)(kws() + WS_H))
#define T_QB()   ((bf16*)(kws() + WS_QB))
#define T_KB()   ((bf16*)(kws() + WS_KB))
#define T_VB()   ((bf16*)(kws() + WS_VB))
#define T_XB()   ((bf16*)(kws() + WS_XB))
#define T_X1B()  ((bf16*)kout())
#define T_X2B()  ((bf16*)(kws() + WS_X2B))
#define T_CMAXO() ((unsigned*)(kws() + WS_CTL + 680 * 1024))
#define T_RHO()  ((float*)(kws() + WS_CTL + 768 * 1024))
#define T_MXC()  ((float*)(kws() + WS_CTL + 832 * 1024))
#define T_SCALES() ((float*)(kws() + WS_CTL + 960 * 1024))
#define T_K8()   ((unsigned char*)(kws() + 761 * MiB))
#define T_X1I8() ((unsigned char*)(kws() + WS_H))
#define T_WSC8() ((unsigned char*)(kws() + 761 * MiB))
#define T_CMAXW() ((float*)(kws() + WS_CTL + 896 * 1024))
#define T_YI8()  ((unsigned char*)(kws() + WS_H))
#define T_RS2()  ((float*)(kws() + WS_CTL + 704 * 1024))
#define T_RSA()  ((float*)(kws() + WS_CTL + 512 * 1024))
#define T_WMAX() ((unsigned*)(kws() + WS_CTL) + CW_WMAX)
#define T_CMAX() ((unsigned*)(kws() + WS_CTL + 640 * 1024))
#define T_WSC()  ((bf16*)(kws() + WS_WSC))
#define T_WUP8() ((unsigned char*)(kws() + WS_WUP8))
#define T_WOUT() ((bf16*)(kws() + WS_WOUT))
#define T_SC()   ((float*)(kws() + WS_SC))
typedef unsigned long long u64;
__device__ __forceinline__ float bflo(unsigned w) { return __uint_as_float(w << 16); }
__device__ __forceinline__ float bfhi(unsigned w) { return __uint_as_float(w & 0xffff0000u); }
__device__ __forceinline__ void unpack8(const v4u w, float (&y)[8]) { y[0] = bflo(w.x); y[1] = bfhi(w.x); y[2] = bflo(w.y); y[3] = bfhi(w.y); y[4] = bflo(w.z); y[5] = bfhi(w.z); y[6] = bflo(w.w); y[7] = bfhi(w.w); }
__device__ __forceinline__ v4u pack8(const float (&y)[8]) { v4u o; o.x = pk2(y[0], y[1]); o.y = pk2(y[2], y[3]); o.z = pk2(y[4], y[5]); o.w = pk2(y[6], y[7]); return o; }
__device__ __forceinline__ float shx(float v, int mask, int lane) { return __builtin_bit_cast(float, __builtin_amdgcn_ds_bpermute((lane ^ mask) << 2, __builtin_bit_cast(int, v))); }
__device__ __forceinline__ float wave_sum(float v, int lane) {
#pragma unroll
    for (int o = 1; o < 64; o <<= 1) v += shx(v, o, lane);
    return v;
}
__device__ __forceinline__ unsigned pk4_e4m3(float a, float b, float c, float d) { return pg8::pk4_fp8(a, b, c, d); }
__device__ __forceinline__ unsigned pk4_i8(float a, float b, float c, float d) {
    const int ia = (int)__builtin_rintf(__builtin_fminf(__builtin_fmaxf(a, -127.f), 127.f)), ib = (int)__builtin_rintf(__builtin_fminf(__builtin_fmaxf(b, -127.f), 127.f));
    const int ic = (int)__builtin_rintf(__builtin_fminf(__builtin_fmaxf(c, -127.f), 127.f)), id = (int)__builtin_rintf(__builtin_fminf(__builtin_fmaxf(d, -127.f), 127.f));
    return ((unsigned)ia & 255u) | (((unsigned)ib & 255u) << 8) | (((unsigned)ic & 255u) << 16) | ((unsigned)id << 24); }
__device__ __forceinline__ float wave_max(float v, int lane) {
#pragma unroll
    for (int o = 1; o < 64; o <<= 1) v = __builtin_fmaxf(v, shx(v, o, lane));
    return v;
}
template <bool I8> __device__ __forceinline__ unsigned pk4_q(float a, float b, float c, float d) { return I8 ? pk4_i8(a, b, c, d) : pk4_e4m3(a, b, c, d); }
__device__ __forceinline__ pg8::i32x6 cvt32_fp6(const float (&x)[32], float mul) {
    pg8::f32x16v a, b;
#pragma unroll
    for (int i = 0; i < 16; ++i) { a[i] = __builtin_fminf(__builtin_fmaxf(x[i] * mul, -7.5f), 7.5f); b[i] = __builtin_fminf(__builtin_fmaxf(x[16 + i] * mul, -7.5f), 7.5f); }
    return __builtin_amdgcn_cvt_scalef32_2xpk16_fp6_f32(a, b, 1.0f);
}
__device__ __forceinline__ void store_fp6_group(unsigned char* base, int pos, int gi, pg8::i32x6 w) {
    const int fq = gi & 3, cls = (pos >> 3) & 1;
    unsigned char* p = base + (size_t)(pos >> 8) * ((size_t)pg8::P6_NT * pg8::P6_TILE) + (size_t)(gi >> 2) * pg8::P6_TILE + (pos & 255) * pg8::P6_KT;
    const int q16 = (fq == 0) ? 0 : (fq == 1) ? 3 : (fq == 2) ? 2 : 5, q8 = ((fq < 2) != (cls != 0)) ? 1 : 4;
    *(GAS v4u*)(p + q16 * 16) = (v4u){(unsigned)w[0], (unsigned)w[1], (unsigned)w[2], (unsigned)w[3]};
    *(GAS unsigned long long*)(p + q8 * 16 + (fq & 1) * 8) = (unsigned long long)(unsigned)w[4] | ((unsigned long long)(unsigned)w[5] << 32);
}
template <bool I8> __device__ __forceinline__ void p0_transpose_item_q8(const float* W, int K, int N, unsigned char* WT, LAS float* scr, int item, int lane, float scale0, const float* rowmax, const float* kgain = nullptr, int kg_rows = 0) {
    const int nblk = N / 32, kb = item / nblk, nb = item % nblk, k0 = 64 * kb, n0 = 32 * nb;
    float ld_[32];
#pragma unroll
    for (int i = 0; i < 32; ++i) ld_[i] = W[(size_t)(k0 + 2 * i + (lane >> 5)) * N + n0 + (lane & 31)];
#pragma unroll
    for (int i = 0; i < 32; ++i) scr[(2 * i + (lane >> 5)) * 33 + (lane & 31)] = ld_[i];
    LDS_WAIT(); asm volatile("" ::: "memory");
    const int c = lane & 3;
    float kg[16];
#pragma unroll
    for (int e = 0; e < 16; ++e) kg[e] = 1.f;
    if (kgain != nullptr && k0 < kg_rows) {
#pragma unroll
        for (int e4 = 0; e4 < 4; ++e4) { const f32x4 g4 = *(const GAS f32x4*)(kgain + k0 + 16 * c + 4 * e4); kg[4 * e4] = g4.x; kg[4 * e4 + 1] = g4.y; kg[4 * e4 + 2] = g4.z; kg[4 * e4 + 3] = g4.w; } }
#pragma unroll
    for (int j = 0; j < 2; ++j) { const int n = (lane >> 2) + 16 * j; const LAS float* s = scr + (16 * c) * 33 + n;
        float scale = scale0; if (I8) { const float mx_ = rowmax[n0 + n]; scale = mx_ > 0.f ? 127.f / mx_ : 0.f; }
        v4u o;
        o.x = pk4_q<I8>(s[0 * 33] * kg[0] * scale, s[1 * 33] * kg[1] * scale, s[2 * 33] * kg[2] * scale, s[3 * 33] * kg[3] * scale); o.y = pk4_q<I8>(s[4 * 33] * kg[4] * scale, s[5 * 33] * kg[5] * scale, s[6 * 33] * kg[6] * scale, s[7 * 33] * kg[7] * scale);
        o.z = pk4_q<I8>(s[8 * 33] * kg[8] * scale, s[9 * 33] * kg[9] * scale, s[10 * 33] * kg[10] * scale, s[11 * 33] * kg[11] * scale); o.w = pk4_q<I8>(s[12 * 33] * kg[12] * scale, s[13 * 33] * kg[13] * scale, s[14 * 33] * kg[14] * scale, s[15 * 33] * kg[15] * scale);
        *(GAS v4u*)(WT + (size_t)(n0 + n) * K + k0 + 16 * c) = o; }
    LDS_WAIT(); asm volatile("" ::: "memory");
}
__device__ __forceinline__ void p0_transpose_item(const float* W, int K, int N, bf16* WT, LAS float* scr, int item, int lane, const float* kgain, int kg_rows) {
    const int nblk = N / 32, kb = item / nblk, nb = item % nblk, k0 = 64 * kb, n0 = 32 * nb;
    float ld_[32];
#pragma unroll
    for (int i = 0; i < 32; ++i) ld_[i] = W[(size_t)(k0 + 2 * i + (lane >> 5)) * N + n0 + (lane & 31)];
#pragma unroll
    for (int i = 0; i < 32; ++i) scr[(2 * i + (lane >> 5)) * 33 + (lane & 31)] = ld_[i];
    LDS_WAIT(); asm volatile("" ::: "memory");
    const int c = lane & 7;
    f32x4 g0 = {1.f, 1.f, 1.f, 1.f}, g1 = g0;
    if (kgain != nullptr && k0 < kg_rows) { g0 = *(const GAS f32x4*)(kgain + k0 + 8 * c); g1 = *(const GAS f32x4*)(kgain + k0 + 8 * c + 4); }
#pragma unroll
    for (int j = 0; j < 4; ++j) { const int n = (lane >> 3) + 8 * j; const LAS float* s = scr + (8 * c) * 33 + n;
        v4u o; o.x = pk2(s[0 * 33] * g0.x, s[1 * 33] * g0.y); o.y = pk2(s[2 * 33] * g0.z, s[3 * 33] * g0.w); o.z = pk2(s[4 * 33] * g1.x, s[5 * 33] * g1.y); o.w = pk2(s[6 * 33] * g1.z, s[7 * 33] * g1.w);
        *(GAS v4u*)(WT + (size_t)(n0 + n) * K + k0 + 8 * c) = o; }
    LDS_WAIT(); asm volatile("" ::: "memory");
}
template <bool FP8COPY> __device__ __forceinline__ void rms_row_to_bf16(const float* xrow, const float* g, bf16* orow, unsigned char* orow8, int lane) {
    const GAS f32x4* xr = (const GAS f32x4*)xrow + lane;
    f32x4 v[16]; float s = 0.f;
#pragma unroll
    for (int j = 0; j < 16; ++j) { v[j] = xr[64 * j]; s += (v[j].x * v[j].x + v[j].y * v[j].y) + (v[j].z * v[j].z + v[j].w * v[j].w); }
    const float r = 1.0f / sqrtf(wave_sum(s, lane) * (1.f / DM) + EPS);
    const GAS f32x4* gr = (const GAS f32x4*)g + lane;
    GAS u64* o8 = (GAS u64*)orow + lane;
#pragma unroll
    for (int j = 0; j < 16; ++j) { const f32x4 gg = gr[64 * j];
        const float y0 = v[j].x * r * gg.x, y1 = v[j].y * r * gg.y, y2 = v[j].z * r * gg.z, y3 = v[j].w * r * gg.w;
        o8[64 * j] = (u64)pk2(y0, y1) | ((u64)pk2(y2, y3) << 32);
        if (FP8COPY) ((GAS unsigned*)orow8)[lane + 64 * j] = pk4_e4m3(y0, y1, y2, y3); }
}
__device__ __forceinline__ void rms_row_to_i8(const float* xrow, const float* g, unsigned char* orow8, float* rs, bf16* xbrow, int lane) {
    const GAS f32x4* xr = (const GAS f32x4*)xrow + lane;
    f32x4 v[16]; float s = 0.f;
#pragma unroll
    for (int j = 0; j < 16; ++j) { v[j] = xr[64 * j]; s += (v[j].x * v[j].x + v[j].y * v[j].y) + (v[j].z * v[j].z + v[j].w * v[j].w);
        ((GAS u64*)xbrow)[lane + 64 * j] = (u64)pk2(v[j].x, v[j].y) | ((u64)pk2(v[j].z, v[j].w) << 32); }
    const float r = 1.0f / sqrtf(wave_sum(s, lane) * (1.f / DM) + EPS);
    const GAS f32x4* gr = (const GAS f32x4*)g + lane;
    float mx = 0.f;
#pragma unroll
    for (int j = 0; j < 16; ++j) { const f32x4 gg = gr[64 * j]; v[j].x = v[j].x * r * gg.x; v[j].y = v[j].y * r * gg.y; v[j].z = v[j].z * r * gg.z; v[j].w = v[j].w * r * gg.w;
        mx = __builtin_fmaxf(mx, __builtin_fmaxf(__builtin_fmaxf(__builtin_fabsf(v[j].x), __builtin_fabsf(v[j].y)), __builtin_fmaxf(__builtin_fabsf(v[j].z), __builtin_fabsf(v[j].w)))); }
    mx = wave_max(mx, lane);
    const float sc = mx > 0.f ? 127.f / mx : 0.f;
#pragma unroll
    for (int j = 0; j < 16; ++j) ((GAS unsigned*)orow8)[lane + 64 * j] = pk4_i8(v[j].x * sc, v[j].y * sc, v[j].z * sc, v[j].w * sc);
    if (lane == 0) *rs = mx * (1.f / 127.f);
}
__device__ __forceinline__ void rms_rowb_to_h2(const bf16* xrow, const float* g, float* rstd_out, unsigned char* h6base, int pos, int lane, unsigned char* x8row, const float h6s) {
    float s = 0.f, mx = 0.f;
#pragma unroll
    for (int j = 0; j < 8; ++j) { const v4u w = *(const GAS v4u*)(xrow + 8 * (lane + 64 * j)); float t8[8]; unpack8(w, t8);
#pragma unroll
        for (int e = 0; e < 8; ++e) { s += t8[e] * t8[e]; mx = __builtin_fmaxf(mx, __builtin_fabsf(t8[e])); } }
    const float r = 1.0f / sqrtf(wave_sum(s, lane) * (1.f / DM) + EPS);
    mx = wave_max(mx, lane);
    if (lane == 0) *rstd_out = r * mx * (1.f / 127.f);
    { const float sc = mx > 0.f ? 127.f / mx : 0.f;
#pragma unroll
      for (int j = 0; j < 8; ++j) { int col = 8 * (lane + 64 * j); asm volatile("" : "+v"(col)); const v4u w = *(const GAS v4u*)(xrow + col); float t8[8]; unpack8(w, t8);
          *(GAS u64*)(x8row + col) = (u64)pk4_i8(t8[0] * sc, t8[1] * sc, t8[2] * sc, t8[3] * sc) | ((u64)pk4_i8(t8[4] * sc, t8[5] * sc, t8[6] * sc, t8[7] * sc) << 32); } }
#pragma unroll
    for (int jj = 0; jj < 2; ++jj) { const int gi = lane + 64 * jj; float y[32];
#pragma unroll
        for (int q = 0; q < 4; ++q) { const v4u w = *(const GAS v4u*)(xrow + 32 * gi + 8 * q); float t8[8]; unpack8(w, t8);
            const f32x4 g0 = *(const GAS f32x4*)(g + 32 * gi + 8 * q), g1 = *(const GAS f32x4*)(g + 32 * gi + 8 * q + 4);
            y[8 * q + 0] = t8[0] * r * g0.x; y[8 * q + 1] = t8[1] * r * g0.y; y[8 * q + 2] = t8[2] * r * g0.z; y[8 * q + 3] = t8[3] * r * g0.w;
            y[8 * q + 4] = t8[4] * r * g1.x; y[8 * q + 5] = t8[5] * r * g1.y; y[8 * q + 6] = t8[6] * r * g1.z; y[8 * q + 7] = t8[7] * r * g1.w; }
        store_fp6_group(h6base, pos, gi, cvt32_fp6(y, h6s)); }
}
__device__ __forceinline__ void p8_rows(const bf16* x2, const float* g, float* out, int m0, int step, int n, int lane) {
    float gn[8][8];
#pragma unroll
    for (int j = 0; j < 8; ++j) { const int col = 8 * (lane + 64 * j); const f32x4 g0 = *(const GAS f32x4*)(g + col), g1 = *(const GAS f32x4*)(g + col + 4);
        gn[j][0] = g0.x; gn[j][1] = g0.y; gn[j][2] = g0.z; gn[j][3] = g0.w; gn[j][4] = g1.x; gn[j][5] = g1.y; gn[j][6] = g1.z; gn[j][7] = g1.w; }
    v4u nx[8];
#pragma unroll
    for (int j = 0; j < 8; ++j) nx[j] = *(const GAS v4u*)(x2 + (size_t)m0 * DM + 8 * (lane + 64 * j));
    for (int k = 0; k < n; ++k) {
        const int m = m0 + k * step;
        float v[8][8]; float s = 0.f;
#pragma unroll
        for (int j = 0; j < 8; ++j) { unpack8(nx[j], v[j]);
#pragma unroll
            for (int e = 0; e < 8; ++e) s += v[j][e] * v[j][e]; }
        if (k + 1 < n) {
#pragma unroll
            for (int j = 0; j < 8; ++j) nx[j] = *(const GAS v4u*)(x2 + (size_t)(m + step) * DM + 8 * (lane + 64 * j)); }
        const float r = 1.0f / sqrtf(wave_sum(s, lane) * (1.f / DM) + EPS);
        float* orow = out + (size_t)m * DM;
#pragma unroll
        for (int j = 0; j < 8; ++j) { const int col = 8 * (lane + 64 * j);
            f32x4 o0, o1; o0.x = v[j][0] * r * gn[j][0]; o0.y = v[j][1] * r * gn[j][1]; o0.z = v[j][2] * r * gn[j][2]; o0.w = v[j][3] * r * gn[j][3];
            o1.x = v[j][4] * r * gn[j][4]; o1.y = v[j][5] * r * gn[j][5]; o1.z = v[j][6] * r * gn[j][6]; o1.w = v[j][7] * r * gn[j][7];
            *(GAS f32x4*)(orow + col) = o0; *(GAS f32x4*)(orow + col + 4) = o1; }
    }
}
__device__ __forceinline__ void rms_rowb_to_f32(const bf16* xrow, const float* g, float* orow, int lane) {
    float v[8][8]; float s = 0.f;
#pragma unroll
    for (int j = 0; j < 8; ++j) { const v4u w = *(const GAS v4u*)(xrow + 8 * (lane + 64 * j)); unpack8(w, v[j]);
#pragma unroll
        for (int e = 0; e < 8; ++e) s += v[j][e] * v[j][e]; }
    const float r = 1.0f / sqrtf(wave_sum(s, lane) * (1.f / DM) + EPS);
#pragma unroll
    for (int j = 0; j < 8; ++j) { const int col = 8 * (lane + 64 * j);
        const f32x4 g0 = *(const GAS f32x4*)(g + col), g1 = *(const GAS f32x4*)(g + col + 4);
        f32x4 o0, o1; o0.x = v[j][0] * r * g0.x; o0.y = v[j][1] * r * g0.y; o0.z = v[j][2] * r * g0.z; o0.w = v[j][3] * r * g0.w; o1.x = v[j][4] * r * g1.x; o1.y = v[j][5] * r * g1.y; o1.z = v[j][6] * r * g1.z; o1.w = v[j][7] * r * g1.w;
        *(GAS f32x4*)(orow + col) = o0; *(GAS f32x4*)(orow + col + 4) = o1; }
}
__device__ __forceinline__ void rms_row_inplace(float* xrow, const float* g, int lane) {
    GAS f32x4* xr = (GAS f32x4*)xrow + lane;
    f32x4 v[16]; float s = 0.f;
#pragma unroll
    for (int j = 0; j < 16; ++j) { v[j] = xr[64 * j]; s += (v[j].x * v[j].x + v[j].y * v[j].y) + (v[j].z * v[j].z + v[j].w * v[j].w); }
    const float r = 1.0f / sqrtf(wave_sum(s, lane) * (1.f / DM) + EPS);
    const GAS f32x4* gr = (const GAS f32x4*)g + lane;
#pragma unroll
    for (int j = 0; j < 16; ++j) { const f32x4 gg = gr[64 * j]; f32x4 o; o.x = v[j].x * r * gg.x; o.y = v[j].y * r * gg.y; o.z = v[j].z * r * gg.z; o.w = v[j].w * r * gg.w; xr[64 * j] = o; }
}
__device__ __forceinline__ void p0_premul_item(Frame& F, int item, const float* sub_keys, const float* w_query, bf16* WSC, const float* gk) {
    constexpr int LDP = 132;
    LAS float* Ks = (LAS float*)(F.lds + RING_OFF);
    LAS float* Ws = Ks + 128 * LDP;
    const int hp = item >> 6, k0 = (item & 63) * 64, tid = F.tid;
    const float* kg = sub_keys + (size_t)hp * 128 * 128;
#pragma unroll
    for (int i = 0; i < 8; ++i) { const int e = tid + 512 * i, r = e >> 5, c4 = e & 31; const f32x4 v = *(const GAS f32x4*)(kg + (size_t)r * 128 + c4 * 4); *(LAS f32x4*)(Ks + r * LDP + c4 * 4) = v; }
#pragma unroll
    for (int i = 0; i < 4; ++i) { const int e = tid + 512 * i, r = e >> 5, c4 = e & 31; const f32x4 v = *(const GAS f32x4*)(w_query + (size_t)(k0 + r) * PQ + hp * 128 + c4 * 4); *(LAS f32x4*)(Ws + r * LDP + c4 * 4) = v; }
    __syncthreads();
    const int lane = tid & 63, w = tid >> 6, r = lane & 15, q = lane >> 4;
    pg8::f32x4 acc[4];
#pragma unroll
    for (int n = 0; n < 4; ++n) acc[n] = (pg8::f32x4){0.f, 0.f, 0.f, 0.f};
#pragma unroll
    for (int st = 0; st < 4; ++st) {
        const f32x4 a0 = *(const LAS f32x4*)(Ks + (16 * w + r) * LDP + 32 * st + 8 * q), a1 = *(const LAS f32x4*)(Ks + (16 * w + r) * LDP + 32 * st + 8 * q + 4);
        v4u aw = {pk2(a0.x, a0.y), pk2(a0.z, a0.w), pk2(a1.x, a1.y), pk2(a1.z, a1.w)}; const pg8::bf16x8 af = __builtin_bit_cast(pg8::bf16x8, aw);
#pragma unroll
        for (int n = 0; n < 4; ++n) {
            const f32x4 b0 = *(const LAS f32x4*)(Ws + (16 * n + r) * LDP + 32 * st + 8 * q), b1 = *(const LAS f32x4*)(Ws + (16 * n + r) * LDP + 32 * st + 8 * q + 4);
            v4u bw = {pk2(b0.x, b0.y), pk2(b0.z, b0.w), pk2(b1.x, b1.y), pk2(b1.z, b1.w)}; const pg8::bf16x8 bf = __builtin_bit_cast(pg8::bf16x8, bw);
            acc[n] = __builtin_amdgcn_mfma_f32_16x16x32_bf16(af, bf, acc[n], 0, 0, 0); }
    }
#pragma unroll
    for (int n = 0; n < 4; ++n) { const float gg = gk[k0 + 16 * n + r];
#pragma unroll
        for (int e = 0; e < 4; ++e) WSC[(size_t)(hp * 128 + 16 * w + 4 * q + e) * DM + k0 + 16 * n + r] = (bf16)f2bf(acc[n][e] * gg); }
    __syncthreads();
}
__device__ __forceinline__ void p0a_absmax(Frame& F) {
    const float* w_in = T_w_in(); constexpr int NCG = IN_COLS / 4, RPT = 56;
    const int t = F.vcu * 512 + F.tid;
    if (t < RPT * NCG) { const int cg = t % NCG, r0 = t / NCG;
        f32x4 m = {0.f, 0.f, 0.f, 0.f};
        for (int r = r0; r < DM; r += 8 * RPT) {
            f32x4 a[8];
#pragma unroll
            for (int u = 0; u < 8; ++u) { const int rr = r + u * RPT; a[u] = *(const GAS f32x4*)(w_in + (size_t)(rr < DM ? rr : r) * IN_COLS + 4 * cg); }
#pragma unroll
            for (int u = 0; u < 8; ++u) { m.x = __builtin_fmaxf(m.x, __builtin_fabsf(a[u].x)); m.y = __builtin_fmaxf(m.y, __builtin_fabsf(a[u].y)); m.z = __builtin_fmaxf(m.z, __builtin_fabsf(a[u].z)); m.w = __builtin_fmaxf(m.w, __builtin_fabsf(a[u].w)); } }
        unsigned* cm = T_CMAX() + 4 * cg;
        __hip_atomic_fetch_max(cm + 0, __float_as_uint(m.x), __ATOMIC_RELAXED, __HIP_MEMORY_SCOPE_AGENT); __hip_atomic_fetch_max(cm + 1, __float_as_uint(m.y), __ATOMIC_RELAXED, __HIP_MEMORY_SCOPE_AGENT);
        __hip_atomic_fetch_max(cm + 2, __float_as_uint(m.z), __ATOMIC_RELAXED, __HIP_MEMORY_SCOPE_AGENT); __hip_atomic_fetch_max(cm + 3, __float_as_uint(m.w), __ATOMIC_RELAXED, __HIP_MEMORY_SCOPE_AGENT); }
    { const float* w_out = T_w_out(); const float* ag = T_attn_out_g(); const int cg = t & 1023, r0 = t >> 10;
      if (r0 < 128) {
        f32x4 m = {0.f, 0.f, 0.f, 0.f};
        for (int r = r0; r < DM; r += 8 * 128) {
            f32x4 a[8]; float gg[8];
#pragma unroll
            for (int u = 0; u < 8; ++u) { const int rr = r + u * 128; a[u] = *(const GAS f32x4*)(w_out + (size_t)rr * DM + 4 * cg); gg[u] = rr < ATTN_W ? __builtin_fabsf(ag[rr]) : 1.f; }
#pragma unroll
            for (int u = 0; u < 8; ++u) { m.x = __builtin_fmaxf(m.x, __builtin_fabsf(a[u].x) * gg[u]); m.y = __builtin_fmaxf(m.y, __builtin_fabsf(a[u].y) * gg[u]); m.z = __builtin_fmaxf(m.z, __builtin_fabsf(a[u].z) * gg[u]); m.w = __builtin_fmaxf(m.w, __builtin_fabsf(a[u].w) * gg[u]); } }
        unsigned* cm = T_CMAXO() + 4 * cg;
        __hip_atomic_fetch_max(cm + 0, __float_as_uint(m.x), __ATOMIC_RELAXED, __HIP_MEMORY_SCOPE_AGENT); __hip_atomic_fetch_max(cm + 1, __float_as_uint(m.y), __ATOMIC_RELAXED, __HIP_MEMORY_SCOPE_AGENT);
        __hip_atomic_fetch_max(cm + 2, __float_as_uint(m.z), __ATOMIC_RELAXED, __HIP_MEMORY_SCOPE_AGENT); __hip_atomic_fetch_max(cm + 3, __float_as_uint(m.w), __ATOMIC_RELAXED, __HIP_MEMORY_SCOPE_AGENT); } }
    if (F.vcu == 0) {
        const float* wd = T_w_down(); const float* wu = T_w_up(); const float* gf = T_norm_ffn_g();
        float sd = 0.f, su = 0.f, sg = 0.f;
#pragma unroll 8
        for (int i = 0; i < 32; ++i) { const unsigned j = (unsigned)(i * 512 + F.tid), idx = (j >> 8) * (unsigned)((size_t)NEXP * DM / 64) + (j & 255u); const float a = wd[idx], c = wu[idx]; sd += a * a; su += c * c; }
#pragma unroll
        for (int i = 0; i < DM / 512; ++i) { const float a = gf[F.tid + 512 * i]; sg += a * a; }
        sd = wave_sum(sd, F.lane); su = wave_sum(su, F.lane); sg = wave_sum(sg, F.lane);
        LAS float* red = (LAS float*)(F.lds + RING_OFF);
        if (F.lane == 0) { red[F.wave] = sd; red[8 + F.wave] = su; red[16 + F.wave] = sg; }
        LDS_WAIT(); __syncthreads();
        if (F.tid == 0) { float a = 0.f, c = 0.f, e = 0.f;
            for (int w = 0; w < NWAVES; ++w) { a += red[w]; c += red[8 + w]; e += red[16 + w]; }
            const float rd = sqrtf(a * (1.f / 16384.f)), ru = sqrtf(c * (1.f / 16384.f)), rg = sqrtf(e * (1.f / DM));
            float* sc = T_SCALES(); sc[0] = rd > 0.f ? 1.9f / rd : 1.f; sc[1] = rg > 0.f ? 1.9f / rg : 1.f; sc[2] = ru > 0.f ? 0.5f / ru : 1.f; }
        __syncthreads();
    }
}
__device__ __forceinline__ void p0_prologue(Frame& F) {
    const int gw = F.vcu * NWAVES + F.wave, NGW = F.G * NWAVES;
    LAS float* scr = (LAS float*)(F.lds + RING_OFF + F.wave * 16384);
    constexpr int I_IN = (DM / 64) * (IN_COLS / 32);
    { const float* w_in = T_w_in(); unsigned char* WIN8 = T_WIN8();
      for (int it = gw; it < I_IN; it += NGW) p0_transpose_item_q8<true>(w_in, DM, IN_COLS, WIN8, scr, it, F.lane, 1.0f, (const float*)T_CMAX()); }
    { const float* x = T_x(); const float* g = T_norm_mix_g(); unsigned char* HI8 = T_HI8(); float* rsA = T_RSA(); bf16* XB = T_XB();
      for (int m = gw; m < M; m += NGW) rms_row_to_i8(x + (size_t)m * DM, g, HI8 + (size_t)m * DM, rsA + m, XB + (size_t)m * DM, F.lane); }
}
__device__ __forceinline__ void side_weight_copies(Frame& F) {
    { unsigned z_ = 0u; asm volatile("" : "+v"(z_)); const int t_ = (F.wave << 6) | (int)__builtin_amdgcn_mbcnt_hi(~0u, __builtin_amdgcn_mbcnt_lo(~0u, z_)); F.tid = t_; F.lane = t_ & 63; }
    const int gw = F.vcu * NWAVES + F.wave, NGW = F.G * NWAVES;
    __syncthreads();
    { const float* sk = T_sub_keys(); const float* wq = T_w_query(); bf16* wsc = T_WSC(); const float* gk = T_norm_ffn_g();
      for (int it = F.vcu; it < 16 * 64; it += F.G) p0_premul_item(F, it, sk, wq, wsc, gk); }
    LAS float* scr = (LAS float*)(F.lds + RING_OFF + F.wave * 16384);
    constexpr int I_OUT = (DM / 64) * (DM / 32), I_UP = (NEXP / 64) * (DM / 32);
    { const float* w_out = T_w_out(); bf16* WOUT = T_WOUT(); const float* ag = T_attn_out_g();
      for (int it = gw; it < I_OUT; it += NGW) p0_transpose_item_q8<true>(w_out, DM, DM, (unsigned char*)WOUT, scr, it, F.lane, 1.0f, (const float*)T_CMAXO(), ag, ATTN_W); }
    { const float* w_up = T_w_up(); unsigned char* WUP8 = T_WUP8(); const float wus = T_SCALES()[2];
      for (int it = gw; it < I_UP; it += NGW) p0_transpose_item_q8<false>(w_up, NEXP, DM, WUP8, scr, it, F.lane, wus, nullptr); }
    { const float w6s = T_SCALES()[0]; const float* w_down = T_w_down(); unsigned char* WD6 = T_WD8(); const size_t n32 = (size_t)NEXP * DM / 32, stride = (size_t)F.G * 512;
      for (size_t i = (size_t)F.vcu * 512 + F.tid; i < n32; i += 2 * stride) {
          f32x4 q[2][8];
#pragma unroll
          for (int u = 0; u < 2; ++u)
#pragma unroll
              for (int j = 0; j < 8; ++j) q[u][j] = *(const GAS f32x4*)(w_down + (i + u * stride) * 32 + 4 * j);
#pragma unroll
          for (int u = 0; u < 2; ++u) { float y[32];
#pragma unroll
              for (int j = 0; j < 8; ++j) { y[4 * j] = q[u][j].x; y[4 * j + 1] = q[u][j].y; y[4 * j + 2] = q[u][j].z; y[4 * j + 3] = q[u][j].w; }
              const size_t gidx = i + u * stride; const int e_ = (int)(gidx >> 7), c_ = e_ & 31, rho_ = 16 * ((c_ >> 2) & 1) + 4 * (c_ >> 3) + (c_ & 3);
                  store_fp6_group(WD6, (e_ & ~31) + rho_, (int)(gidx & 127), cvt32_fp6(y, w6s)); } } }
    VM_WAIT(); LDS_WAIT();
    __syncthreads();
}
__device__ __forceinline__ void p3b_quant_token(Frame& F, int t, const bf16* Y, unsigned char* YI8, const float* mxc_in, float* rs, float* rho) {
    const int lane = F.lane;
    const bf16* yrow = Y + (size_t)t * DM;
    float v[4][8]; float ss = 0.f;
#pragma unroll
    for (int i = 0; i < 4; ++i) { const v4u w = *(const GAS v4u*)(yrow + 8 * (lane + 64 * i)); unpack8(w, v[i]);
#pragma unroll
        for (int e = 0; e < 8; ++e) ss += v[i][e] * v[i][e]; }
    const float r = 1.0f / sqrtf(wave_sum(ss, lane) * (1.f / ATTN_W) + EPS);
    float mxa = 0.f;
#pragma unroll
    for (int i = 0; i < 4; ++i)
#pragma unroll
        for (int e = 0; e < 8; ++e) { v[i][e] *= r; mxa = __builtin_fmaxf(mxa, __builtin_fabsf(v[i][e])); }
    mxa = wave_max(mxa, lane);
    float mxc = mxc_in[t]; if (!(mxc > 0.f)) mxc = mxa;
    const float sa = mxa > 0.f ? 127.f / mxa : 0.f;
    unsigned char* orow = YI8 + (size_t)t * DM;
#pragma unroll
    for (int i = 0; i < 4; ++i) { int col = 8 * (lane + 64 * i); asm volatile("" : "+v"(col));
        *(GAS u64*)(orow + col) = (u64)pk4_i8(v[i][0] * sa, v[i][1] * sa, v[i][2] * sa, v[i][3] * sa) | ((u64)pk4_i8(v[i][4] * sa, v[i][5] * sa, v[i][6] * sa, v[i][7] * sa) << 32); }
    if (lane == 0) { rs[t] = mxc * (1.f / 127.f); rho[t] = mxc > 0.f ? mxa / mxc : 0.f; }
}
__device__ __forceinline__ void wsc_quant_row(const bf16* wrow, unsigned char* orow, float* cmax, int lane) {
    float v[8][8]; float mx = 0.f;
#pragma unroll
    for (int i = 0; i < 8; ++i) { const v4u w = *(const GAS v4u*)(wrow + 8 * (lane + 64 * i)); unpack8(w, v[i]);
#pragma unroll
        for (int e = 0; e < 8; ++e) mx = __builtin_fmaxf(mx, __builtin_fabsf(v[i][e])); }
    mx = wave_max(mx, lane);
    const float sc = mx > 0.f ? 127.f / mx : 0.f;
#pragma unroll
    for (int i = 0; i < 8; ++i) { int col = 8 * (lane + 64 * i); asm volatile("" : "+v"(col));
        *(GAS u64*)(orow + col) = (u64)pk4_i8(v[i][0] * sc, v[i][1] * sc, v[i][2] * sc, v[i][3] * sc) | ((u64)pk4_i8(v[i][4] * sc, v[i][5] * sc, v[i][6] * sc, v[i][7] * sc) << 32); }
    if (lane == 0) *cmax = mx;
}
constexpr float K8_CLIP = 4.5f;
__device__ __forceinline__ float k8_max(const float* k_norm_g, int lane) { return K8_CLIP * wave_max(__builtin_fmaxf(__builtin_fabsf(k_norm_g[lane]), __builtin_fabsf(k_norm_g[64 + lane])), lane); }
__device__ __forceinline__ void p2_k_token(Frame& F, int t, const float (&inv)[8], bf16* PROJ, const float* k_norm_g, unsigned char* K8, const float sk) {
    const int lane = F.lane, lp = lane & 15, s = t & (SEQ - 1);
    const bool colpart = (lp >> 3) != 0, first = ((lp >> 2) & 1) == 0;
    const float pos = (float)(colpart ? (s & (GRID_W - 1)) : (s / GRID_W));
    float cs[8], sn[8];
#pragma unroll
    for (int e = 0; e < 8; ++e) { const float ang = pos * inv[e]; float rev = ang * 0.15915494309189535f; rev = rev - floorf(rev); cs[e] = __builtin_amdgcn_cosf(rev); sn[e] = __builtin_amdgcn_sinf(rev); }
    bf16* p = PROJ + (size_t)t * IN_COLS + C_K + 8 * lane;
    const v4u raw = *(const GAS v4u*)p;
    float y[8]; unpack8(raw, y);
    float ss = 0.f;
#pragma unroll
    for (int e = 0; e < 8; ++e) ss += y[e] * y[e];
    ss += shx(ss, 1, lane); ss += shx(ss, 2, lane); ss += shx(ss, 4, lane); ss += shx(ss, 8, lane);
    const float r = 1.0f / sqrtf(ss * (1.f / HD) + EPS);
    const f32x4 g0 = *(const GAS f32x4*)(k_norm_g + 8 * lp), g1 = *(const GAS f32x4*)(k_norm_g + 8 * lp + 4);
    const float gg[8] = {g0.x, g0.y, g0.z, g0.w, g1.x, g1.y, g1.z, g1.w};
    float o[8];
#pragma unroll
    for (int e = 0; e < 8; ++e) y[e] = y[e] * r * gg[e];
#pragma unroll
    for (int e = 0; e < 8; ++e) { const float pr = shx(y[e], 4, lane); o[e] = y[e] * cs[e] + (first ? -pr : pr) * sn[e]; }
    { const int b_ = t / SEQ, head = lane >> 4;
      *(GAS u64*)(K8 + ((size_t)(b_ * NKVH + head) * SEQ + s) * HD + 8 * lp) = (u64)pk4_i8(o[0] * sk, o[1] * sk, o[2] * sk, o[3] * sk) | ((u64)pk4_i8(o[4] * sk, o[5] * sk, o[6] * sk, o[7] * sk) << 32); }
}
__device__ __forceinline__ void p2_conv_run(Frame& F, int t0, int n, const bf16* PROJ, unsigned char* YI8, float* mxc_out, const float* conv_w, const float* conv_out_g) {
    const int lane = F.lane;
    float uL[4][8], u0[4][8];
    { const int s0 = t0 & (SEQ - 1); const bool hasL = s0 != 0; const float fL = hasL ? 1.f : 0.f;
      const bf16* r0 = PROJ + (size_t)t0 * IN_COLS; const bf16* rL = hasL ? r0 - IN_COLS : r0;
#pragma unroll
      for (int i = 0; i < 4; ++i) { const int col = 8 * (lane + 64 * i);
          const v4u cxa = *(const GAS v4u*)(rL + C_CX + col), gca = *(const GAS v4u*)(rL + C_GC + col), cxb = *(const GAS v4u*)(r0 + C_CX + col), gcb = *(const GAS v4u*)(r0 + C_GC + col);
          float a[8], b[8], c[8], d[8]; unpack8(cxa, a); unpack8(gca, b); unpack8(cxb, c); unpack8(gcb, d);
#pragma unroll
          for (int e = 0; e < 8; ++e) { uL[i][e] = a[e] * b[e] * fL; u0[i][e] = c[e] * d[e]; } } }
    for (int k = 0; k < n; ++k) {
        const int t = t0 + k, s = t & (SEQ - 1); const bool hasR = s != SEQ - 1; const float fR = hasR ? 1.f : 0.f;
        const bf16* r0 = PROJ + (size_t)t * IN_COLS; const bf16* rR = hasR ? r0 + IN_COLS : r0;
        v4u cxR[4], gcR[4], gbr[4];
#pragma unroll
        for (int i = 0; i < 4; ++i) { const int col = 8 * (lane + 64 * i); cxR[i] = *(const GAS v4u*)(rR + C_CX + col); gcR[i] = *(const GAS v4u*)(rR + C_GC + col); gbr[i] = *(const GAS v4u*)(r0 + C_GB + col); }
        float o[4][8]; float ss = 0.f;
#pragma unroll
        for (int i = 0; i < 4; ++i) {
            int col = 8 * (lane + 64 * i); asm volatile("" : "+v"(col));
            float a[8], b[8], gb[8]; unpack8(cxR[i], a); unpack8(gcR[i], b); unpack8(gbr[i], gb);
            const float* w = conv_w + col;
            const f32x4 w0a = *(const GAS f32x4*)w, w0b = *(const GAS f32x4*)(w + 4), w1a = *(const GAS f32x4*)(w + CONV_W), w1b = *(const GAS f32x4*)(w + CONV_W + 4), w2a = *(const GAS f32x4*)(w + 2 * CONV_W), w2b = *(const GAS f32x4*)(w + 2 * CONV_W + 4);
            const float w0[8] = {w0a.x, w0a.y, w0a.z, w0a.w, w0b.x, w0b.y, w0b.z, w0b.w}, w1[8] = {w1a.x, w1a.y, w1a.z, w1a.w, w1b.x, w1b.y, w1b.z, w1b.w}, w2[8] = {w2a.x, w2a.y, w2a.z, w2a.w, w2b.x, w2b.y, w2b.z, w2b.w};
#pragma unroll
            for (int e = 0; e < 8; ++e) { const float uR = a[e] * b[e] * fR; const float cv = gb[e] * (uL[i][e] * w0[e] + u0[i][e] * w1[e] + uR * w2[e]); o[i][e] = cv; ss += cv * cv; uL[i][e] = u0[i][e]; u0[i][e] = uR; }
            asm volatile("" : "+v"(ss) :: "memory"); __builtin_amdgcn_sched_barrier(0);
        }
        const float r = 1.0f / sqrtf(wave_sum(ss, lane) * (1.f / CONV_W) + EPS);
        float mx = 0.f;
#pragma unroll
        for (int i = 0; i < 4; ++i) { int col = 8 * (lane + 64 * i); asm volatile("" : "+v"(col));
            const f32x4 g0 = *(const GAS f32x4*)(conv_out_g + col), g1 = *(const GAS f32x4*)(conv_out_g + col + 4);
            const float gg[8] = {g0.x, g0.y, g0.z, g0.w, g1.x, g1.y, g1.z, g1.w};
#pragma unroll
            for (int e = 0; e < 8; ++e) { o[i][e] = o[i][e] * r * gg[e]; mx = __builtin_fmaxf(mx, __builtin_fabsf(o[i][e])); } }
        mx = wave_max(mx, lane);
        const float sc = mx > 0.f ? 127.f / mx : 0.f;
        unsigned char* yrow = YI8 + (size_t)t * DM + ATTN_W;
#pragma unroll
        for (int i = 0; i < 4; ++i) { int col = 8 * (lane + 64 * i); asm volatile("" : "+v"(col));
            *(GAS u64*)(yrow + col) = (u64)pk4_i8(o[i][0] * sc, o[i][1] * sc, o[i][2] * sc, o[i][3] * sc) | ((u64)pk4_i8(o[i][4] * sc, o[i][5] * sc, o[i][6] * sc, o[i][7] * sc) << 32); }
        if (lane == 0) mxc_out[t] = mx;
    }
}
__device__ __forceinline__ void p3b_token(Frame& F, int t, bf16* Y, const float* attn_out_g) {
    const int lane = F.lane;
    bf16* yrow = Y + (size_t)t * DM;
    float v[4][8]; float ss = 0.f;
#pragma unroll
    for (int i = 0; i < 4; ++i) { const v4u w = *(const GAS v4u*)(yrow + 8 * (lane + 64 * i)); unpack8(w, v[i]);
#pragma unroll
        for (int e = 0; e < 8; ++e) ss += v[i][e] * v[i][e]; }
    const float r = 1.0f / sqrtf(wave_sum(ss, lane) * (1.f / ATTN_W) + EPS);
#pragma unroll
    for (int i = 0; i < 4; ++i) { int col = 8 * (lane + 64 * i); asm volatile("" : "+v"(col));
        const f32x4 g0 = *(const GAS f32x4*)(attn_out_g + col), g1 = *(const GAS f32x4*)(attn_out_g + col + 4);
        const float gg[8] = {g0.x, g0.y, g0.z, g0.w, g1.x, g1.y, g1.z, g1.w};
        float y[8];
#pragma unroll
        for (int e = 0; e < 8; ++e) y[e] = v[i][e] * r * gg[e];
        *(GAS v4u*)(yrow + col) = pack8(y); }
}
__device__ __forceinline__ unsigned fkey(float f) { const unsigned u = __float_as_uint(f); return u ^ ((u >> 31) ? 0xFFFFFFFFu : 0x80000000u); }
__device__ __forceinline__ int popc64(u64 m) { return __builtin_popcountll(m); }
__device__ __forceinline__ int lanes_below(u64 m) { return (int)__builtin_amdgcn_mbcnt_hi((unsigned)(m >> 32), __builtin_amdgcn_mbcnt_lo((unsigned)m, 0u)); }
template <int NS> __device__ __forceinline__ unsigned topk_thresh(const unsigned (&k)[NS]) {
    unsigned T = 0u;
    for (int bit = 31; bit >= 0; --bit) {
        const unsigned cand = T | (1u << bit); int cnt = 0;
#pragma unroll
        for (int j = 0; j < NS; ++j) cnt += popc64(__ballot(k[j] >= cand));
        if (cnt >= PTOPK) { T = cand; if (cnt == PTOPK) break; }
    }
    return T;
}
template <int NS> __device__ __forceinline__ void topk_select(const unsigned (&k)[NS], unsigned T, bool (&sel)[NS], int (&pos)[NS]) {
    int ngt = 0;
#pragma unroll
    for (int j = 0; j < NS; ++j) ngt += popc64(__ballot(k[j] > T));
    int need = PTOPK - ngt, eqbase = 0, base = 0;
#pragma unroll
    for (int j = 0; j < NS; ++j) {
        const bool eq = k[j] == T; const u64 me = __ballot(eq);
        const bool s = (k[j] > T) || (eq && (eqbase + lanes_below(me)) < need);
        eqbase += popc64(me);
        const u64 ms = __ballot(s);
        sel[j] = s; pos[j] = base + lanes_below(ms); base += popc64(ms);
    }
}
__device__ __forceinline__ float fkey_inv(unsigned k) { return __uint_as_float((k & 0x80000000u) ? (k ^ 0x80000000u) : ~k); }
__device__ __forceinline__ void ce_desc(unsigned& a, unsigned& b) { const unsigned hi = a > b ? a : b, lo = a > b ? b : a; a = hi; b = lo; }
__device__ __forceinline__ void sort16_desc(unsigned (&a)[16]) {
#pragma unroll
    for (int k = 2; k <= 16; k <<= 1)
#pragma unroll
        for (int j = k >> 1; j > 0; j >>= 1)
#pragma unroll
            for (int i = 0; i < 16; ++i) { const int l = i ^ j; if (l > i) { if ((i & k) == 0) ce_desc(a[i], a[l]); else ce_desc(a[l], a[i]); } }
}
__device__ __forceinline__ void merge16_desc(unsigned (&top)[16], const unsigned (&b)[16]) {
#pragma unroll
    for (int i = 0; i < 16; ++i) top[i] = top[i] > b[15 - i] ? top[i] : b[15 - i];
#pragma unroll
    for (int j = 8; j > 0; j >>= 1)
#pragma unroll
        for (int i = 0; i < 16; ++i) { const int l = i ^ j; if (l > i) ce_desc(top[i], top[l]); }
}
constexpr int P5_TB_STRIDE = 36;
constexpr int P5_TB_BYTES = 64 * P5_TB_STRIDE * 4;
constexpr int P5_LIST_OFF = 98304;
static_assert(NWAVES * P5_TB_BYTES <= P5_LIST_OFF && P5_LIST_OFF + 512 * 64 <= RING_BYTES && NEXP * 4 <= P5_LIST_OFF, "top-k phase LDS map");
__device__ __forceinline__ void p5_topk_phase(Frame& F) {
    const int lane = F.lane, tid = F.tid, w = F.wave;
    const float* SC = T_SC(); unsigned char* G8 = T_G8();
    { unsigned char* z0 = G8 + (size_t)F.vcu * 64 * NEXP + (size_t)tid * 16;
#pragma unroll 8
      for (int i = 0; i < (64 * NEXP) / (NWAVES * 64 * 16); ++i) *(GAS v4u*)(z0 + (size_t)i * (NWAVES * 64 * 16)) = (v4u){0u, 0u, 0u, 0u}; }
    {
        LAS float* tb = (LAS float*)(F.lds + RING_OFF + w * P5_TB_BYTES);
        const float* SCw = SC + ((size_t)(F.vcu * NWAVES + w) * 64) * 256;
        const int lp = lane >> 3, lq = lane & 7;
        unsigned S[2][16];
        f32x4 pf[8];
#pragma unroll
        for (int i = 0; i < 8; ++i) pf[i] = *(const GAS f32x4*)(SCw + (size_t)(lp + 8 * i) * 256 + 4 * lq);
#pragma unroll
        for (int p = 0; p < 2; ++p) {
            unsigned top[16];
#pragma unroll
            for (int i = 0; i < 16; ++i) top[i] = 0u;
#pragma unroll 1
            for (int sb = 0; sb < 4; ++sb) {
#pragma unroll
                for (int i = 0; i < 8; ++i) *(LAS f32x4*)(tb + (lp + 8 * i) * P5_TB_STRIDE + 4 * lq) = pf[i];
                { const int nx = p * 4 + sb + 1;
                  if (nx < 8) {
#pragma unroll
                      for (int i = 0; i < 8; ++i) pf[i] = *(const GAS f32x4*)(SCw + (size_t)(lp + 8 * i) * 256 + nx * 32 + 4 * lq); } }
                LDS_WAIT(); asm volatile("" ::: "memory");
#pragma unroll
                for (int hb = 0; hb < 2; ++hb) {
                    unsigned k[16];
#pragma unroll
                    for (int qd = 0; qd < 4; ++qd) { const f32x4 x = *(const LAS f32x4*)(tb + lane * P5_TB_STRIDE + 16 * hb + 4 * qd);
                        const unsigned nb = 127u - (unsigned)(32 * sb + 16 * hb + 4 * qd);
                        k[4 * qd + 0] = (fkey(x.x) & ~127u) | nb; k[4 * qd + 1] = (fkey(x.y) & ~127u) | (nb - 1u); k[4 * qd + 2] = (fkey(x.z) & ~127u) | (nb - 2u); k[4 * qd + 3] = (fkey(x.w) & ~127u) | (nb - 3u); }
                    sort16_desc(k); merge16_desc(top, k);
                }
                LDS_WAIT(); asm volatile("" ::: "memory");
            }
#pragma unroll
            for (int i = 0; i < 16; ++i) S[p][i] = top[i];
        }
        float v0[16], v1[16];
#pragma unroll
        for (int i = 0; i < 16; ++i) { v0[i] = fkey_inv(S[0][i] & ~127u); v1[i] = fkey_inv(S[1][i] & ~127u); }
        unsigned ctop[16];
#pragma unroll
        for (int b = 0; b < 16; ++b) ctop[b] = fkey(v0[0] + v1[b]);
        {
            unsigned kb[16]; int n = 0;
#pragma unroll
            for (int a = 1; a < 16; ++a)
#pragma unroll
                for (int b = 0; b < 16 / (a + 1); ++b) { kb[n & 15] = fkey(v0[a] + v1[b]); ++n;
                    if ((n & 15) == 0) { sort16_desc(kb); merge16_desc(ctop, kb); } }
#pragma unroll
            for (int i = 0; i < 16; ++i) if (i >= (n & 15)) kb[i] = 0u;
            sort16_desc(kb); merge16_desc(ctop, kb);
        }
        const unsigned theta = ctop[15]; const float mx = v0[0] + v1[0];
        float den = 0.f;
#pragma unroll
        for (int a = 0; a < 16; ++a)
#pragma unroll
            for (int b = 0; b < 16 / (a + 1); ++b) { const float sm = v0[a] + v1[b]; den += (fkey(sm) >= theta) ? __expf(sm - mx) : 0.f; }
        const float rden = 1.0f / den;
        LAS unsigned* lst = (LAS unsigned*)(F.lds + RING_OFF + P5_LIST_OFF) + (w * 64 + lane) * 16;
#pragma unroll
        for (int i = 0; i < 4; ++i) *(LAS v4u*)(lst + 4 * i) = (v4u){0u, 0u, 0u, 0u};
        int cnt = 0;
#pragma unroll
        for (int a = 0; a < 16; ++a)
#pragma unroll
            for (int b = 0; b < 16 / (a + 1); ++b) { const float sm = v0[a] + v1[b];
                if (fkey(sm) >= theta && cnt < 16) { const unsigned eid = (127u - (S[0][a] & 127u)) * NKEYS + (127u - (S[1][b] & 127u));
                    lst[cnt] = (f2bf(__expf(sm - mx) * rden) << 16) | eid; ++cnt; } }
    }
    LDS_WAIT();
    __syncthreads();
    unsigned ent[16];
    { const LAS unsigned* lists = (const LAS unsigned*)(F.lds + RING_OFF + P5_LIST_OFF);
#pragma unroll
      for (int r = 0; r < 16; ++r) ent[r] = lists[(4 * r + (tid >> 7)) * 128 + (tid & 127)]; }
    LDS_WAIT(); VM_WAIT();
    __syncthreads();
    for (int u = tid; u < (4 * NEXP * 2) / 16; u += NWAVES * 64) ((LAS v4u*)(F.lds + RING_OFF))[u] = (v4u){0u, 0u, 0u, 0u};
    LDS_WAIT();
    __syncthreads();
    LAS unsigned* row = (LAS unsigned*)(F.lds + RING_OFF + (tid >> 7) * (NEXP * 2));
    unsigned prev_e = 0u, prev_v = 0u;
#pragma unroll
    for (int r = 0; r < 16; ++r) {
        const unsigned e = ent[r], eid = e & 0x3fffu, val = (unsigned)__builtin_rintf(__uint_as_float(e & 0xffff0000u) * 8000.f);
        if (prev_e != 0u) __hip_atomic_fetch_add(row + ((prev_e & 0x3fffu) >> 1), (0u - prev_v) << (16 * (prev_e & 1u)), __ATOMIC_RELAXED, __HIP_MEMORY_SCOPE_WORKGROUP);
        if (e != 0u) __hip_atomic_fetch_add(row + (eid >> 1), val << (16 * (eid & 1u)), __ATOMIC_RELAXED, __HIP_MEMORY_SCOPE_WORKGROUP);
        prev_e = e; prev_v = val;
        LDS_WAIT();
        __syncthreads();
        if (e != 0u) { const unsigned c = eid >> 4;
            const v4u a = *(const LAS v4u*)(row + 8 * c), bq = *(const LAS v4u*)(row + 8 * c + 4);
            constexpr float K = G_SCALE / 8000.f;
            v4u o;
            o.x = pk4_e4m3((float)(a.x & 0xffffu) * K, (float)(a.x >> 16) * K, (float)(a.y & 0xffffu) * K, (float)(a.y >> 16) * K); o.y = pk4_e4m3((float)(a.z & 0xffffu) * K, (float)(a.z >> 16) * K, (float)(a.w & 0xffffu) * K, (float)(a.w >> 16) * K);
            o.z = pk4_e4m3((float)(bq.x & 0xffffu) * K, (float)(bq.x >> 16) * K, (float)(bq.y & 0xffffu) * K, (float)(bq.y >> 16) * K); o.w = pk4_e4m3((float)(bq.z & 0xffffu) * K, (float)(bq.z >> 16) * K, (float)(bq.w & 0xffffu) * K, (float)(bq.w >> 16) * K);
            *(GAS v4u*)(G8 + (size_t)(F.vcu * 64 + 4 * r + (tid >> 7)) * NEXP + 16 * c) = o; }
        LDS_WAIT();
        __syncthreads();
    }
}

struct P1Order : pg8::StaticOrder {
    const bf16* PROJ; const float* kg; unsigned char* K8; float sk; int wave;
    __device__ __forceinline__ void done(const pg8::Unit& u) const {
        if (u.pn != C_K / 256 && u.pn != C_K / 256 + 1) return;
        asm volatile("s_waitcnt vmcnt(0)" ::: "memory"); __builtin_amdgcn_s_barrier();
        unsigned z_ = 0u; asm volatile("" : "+v"(z_)); const int lane = (int)__builtin_amdgcn_mbcnt_hi(~0u, __builtin_amdgcn_mbcnt_lo(~0u, z_));
        const int lp = lane & 15, head = (u.pn - C_K / 256) * 2 + ((lane >> 4) & 1);
        const bool colpart = (lp >> 3) != 0, first = ((lp >> 2) & 1) == 0;
        float inv[8];
#pragma unroll
        for (int e = 0; e < 8; ++e) inv[e] = exp2f(-(float)(8 * (lane & 3) + e) * (13.287712379549449f / 32.0f));
        const f32x4 g0 = *(const GAS f32x4*)(kg + 8 * lp), g1 = *(const GAS f32x4*)(kg + 8 * lp + 4);
        const float gg[8] = {g0.x, g0.y, g0.z, g0.w, g1.x, g1.y, g1.z, g1.w};
#pragma unroll 2
        for (int i = 0; i < 16; ++i) {
            const int t = u.pm * 256 + wave * 32 + 2 * i + (lane >> 5), s = t & (SEQ - 1);
            const float pos = (float)(colpart ? (s & (GRID_W - 1)) : (s / GRID_W));
            float cs[8], sn[8];
#pragma unroll
            for (int e = 0; e < 8; ++e) { const float ang = pos * inv[e]; float rev = ang * 0.15915494309189535f; rev = rev - floorf(rev); cs[e] = __builtin_amdgcn_cosf(rev); sn[e] = __builtin_amdgcn_sinf(rev); }
            const v4u raw = *(const GAS v4u*)(PROJ + (size_t)t * IN_COLS + C_K + head * HD + 8 * lp);
            float y[8]; unpack8(raw, y);
            float ss = 0.f;
#pragma unroll
            for (int e = 0; e < 8; ++e) ss += y[e] * y[e];
            ss += shx(ss, 1, lane); ss += shx(ss, 2, lane); ss += shx(ss, 4, lane); ss += shx(ss, 8, lane);
            const float r = 1.0f / sqrtf(ss * (1.f / HD) + EPS);
            float o[8];
#pragma unroll
            for (int e = 0; e < 8; ++e) y[e] = y[e] * r * gg[e];
#pragma unroll
            for (int e = 0; e < 8; ++e) { const float pr = shx(y[e], 4, lane); o[e] = y[e] * cs[e] + (first ? -pr : pr) * sn[e]; }
            const int b_ = t / SEQ;
            *(GAS u64*)(K8 + ((size_t)(b_ * NKVH + head) * SEQ + s) * HD + 8 * lp) = (u64)pk4_i8(o[0] * sk, o[1] * sk, o[2] * sk, o[3] * sk) | ((u64)pk4_i8(o[4] * sk, o[5] * sk, o[6] * sk, o[7] * sk) << 32);
        }
    }
};

__global__ void __launch_bounds__(NWAVES * 64, 2) hymba_fwd(Args args) {
    extern __shared__ __attribute__((aligned(16))) unsigned char lds[];
    Frame F;
    F.lds = (LAS unsigned char*)lds;
    F.MISC = (volatile LAS unsigned*)(F.lds + MISC_OFF);
    F.wave = __builtin_amdgcn_readfirstlane((int)threadIdx.x >> 6);
#define FRESH_IDS() do { unsigned z_ = 0u; asm volatile("" : "+v"(z_));   \
        const int t_ = (F.wave << 6) | (int)__builtin_amdgcn_mbcnt_hi(~0u, __builtin_amdgcn_mbcnt_lo(~0u, z_)); F.tid = t_; F.lane = t_ & 63; } while (0)
    FRESH_IDS();
    F.G = gridDim.x;
    for (int u = F.tid; u < (LDS_BYTES - LDSCTL_OFF) / 4; u += NWAVES * 64) ((LAS unsigned*)(F.lds + LDSCTL_OFF))[u] = 0u;
    __syncthreads();
    { const int bx = (int)blockIdx.x; F.vcu = (F.G % 8 == 0) ? (bx % 8) * (F.G / 8) + bx / 8 : bx; F.cid = bx; }
    XcdBarrier bar = xcd_barrier_post((unsigned*)(kws() + WS_CTL) + CW_BAR, F.MISC + 8);
#define GRID_BAR() do { xcd_barrier(bar); FRESH_IDS(); } while (0)
    const int gw = F.vcu * NWAVES + F.wave, NGW = F.G * NWAVES;
    const int nph = *(const CAS4 int*)(kargs() + 136);

    p0a_absmax(F);
    GRID_BAR();
    p0_prologue(F);
#if defined(HY_PROBE_P0)
    GRID_BAR(); p0_prologue(F); GRID_BAR(); p0_prologue(F);
#endif
    GRID_BAR();
    {
        pg8::Gemm g{(const bf16*)T_HI8(), (const bf16*)T_WIN8(), M, IN_COLS, DM / 2}; P1Order S; S.init(M, IN_COLS, F.G, F.cid);
        S.PROJ = T_PROJ(); S.kg = T_k_norm_g(); S.K8 = T_K8(); S.sk = 127.f / k8_max(T_k_norm_g(), F.lane); S.wave = F.wave;
        pg8::EpiBf16I8 E{T_PROJ(), IN_COLS, T_RSA(), (const float*)T_CMAX()};
        pg8::gemm_phase<pg8::EpiBf16I8, P1Order, true, true, 2>(F.lds + RING_OFF, g, S, E, F.wave);
#if defined(HY_PROBE_P1)
        __syncthreads(); pg8::gemm_phase<pg8::EpiBf16I8, pg8::StaticOrder, true, true, 2>(F.lds + RING_OFF, g, S, E, F.wave);
#endif
    }
    GRID_BAR();
#define HY_SIDE() do { side_weight_copies(F); { const bf16* PROJ_ = T_PROJ(); unsigned char* Y8_ = T_YI8(); float* mxc_ = T_MXC(); const float* cw_ = T_conv_w(); const float* cg_ = T_conv_out_g(); \
        const int gw_ = F.vcu * NWAVES + F.wave, tpw_ = M / (F.G * NWAVES); p2_conv_run(F, gw_ * tpw_, tpw_, PROJ_, Y8_, mxc_, cw_, cg_); } } while (0)
#define HY_ATTN_UNIT(i, NOSH) do { int L_; if (F.G == 256) L_ = (F.vcu >> 5) * 128 + (i) * 32 + (F.vcu & 31); else L_ = (i) * F.G + F.vcu; \
        if (L_ < BATCH * NQH * (SEQ / 256)) { const int bkv = L_ >> 7, rem = L_ & 127, b = bkv >> 2, kvh = bkv & 3, h = kvh * 4 + (rem >> 5), qb = rem & 31; const size_t rowb = (size_t)b * SEQ; \
            attn128::attn_dense_body<attn128::bf16, NOSH, true, true>(P + (rowb + (size_t)qb * 256) * IN_COLS + C_Q + h * HD, (const attn128::bf16*)(K8a + (size_t)bkv * SEQ * HD), P + rowb * IN_COLS + C_V + kvh * HD, \
                                                     Yb + (rowb + (size_t)qb * 256) * DM + h * HD, SEQ, (char*)lds + RING_OFF, F.wave, qgain, qb * 256, kinv); } } while (0)
    if (nph > 3) {
        const attn128::bf16* P = (const attn128::bf16*)T_PROJ(); attn128::bf16* Yb = (attn128::bf16*)T_Y(); const float* qgain = T_q_norm_g();
        const unsigned char* K8a = T_K8(); const float kinv = k8_max(T_k_norm_g(), F.lane) * (1.f / 127.f);
        bool noshift;
        { const float* qg = T_q_norm_g(); const float* kg = T_k_norm_g();
          const float gq = wave_max(__builtin_fmaxf(__builtin_fabsf(qg[F.lane]), __builtin_fabsf(qg[64 + F.lane])), F.lane), gk = wave_max(__builtin_fmaxf(__builtin_fabsf(kg[F.lane]), __builtin_fabsf(kg[64 + F.lane])), F.lane);
          noshift = __builtin_amdgcn_readfirstlane((int)(1.01f * 128.f * gq * gk * attn128::SCALE * 1.4426950408889634f <= 60.f)) != 0; }
        const int nun = (F.G == 256) ? 4 : (BATCH * NQH * (SEQ / 256) + F.G - 1) / F.G, k0 = (F.G == 256) ? (F.vcu & 3) : 0;
        int i = 0;
        if (noshift) {
#pragma unroll 1
            for (; i < k0; ++i) HY_ATTN_UNIT(i, true);
            HY_SIDE();
#pragma unroll 1
            for (; i < nun; ++i) HY_ATTN_UNIT(i, true);
        } else {
#pragma unroll 1
            for (; i < k0; ++i) HY_ATTN_UNIT(i, false);
            HY_SIDE();
#pragma unroll 1
            for (; i < nun; ++i) HY_ATTN_UNIT(i, false);
        }
        __syncthreads();
    } else HY_SIDE();
#undef HY_ATTN_UNIT
#undef HY_SIDE
    GRID_BAR();
    { const bf16* Y = T_Y(); unsigned char* YI8 = T_YI8(); const float* mxc = T_MXC(); float* rs = T_RSA(); float* rho = T_RHO(); for (int t = gw; t < M; t += NGW) p3b_quant_token(F, t, Y, YI8, mxc, rs, rho); }
    { const bf16* wsc = T_WSC(); unsigned char* w8 = T_WSC8(); float* cm = T_CMAXW(); for (int j = gw; j < PQ; j += NGW) wsc_quant_row(wsc + (size_t)j * DM, w8 + (size_t)j * DM, cm + j, F.lane); }
    GRID_BAR();
    {
        pg8::Gemm g{(const bf16*)T_YI8(), T_WOUT(), M, DM, DM / 2}; pg8::StaticOrder S; S.init(M, DM, F.G, F.cid);
        pg8::EpiResBf16I8 E{T_XB(), T_X1B(), DM, T_RSA(), (const float*)T_CMAXO(), T_RHO()};
        pg8::gemm_phase<pg8::EpiResBf16I8, pg8::StaticOrder, true, true, 2, true>(F.lds + RING_OFF, g, S, E, F.wave);
    }
    GRID_BAR();
    if (nph > 5) {
    { const bf16* x1 = T_X1B(); const float* g = T_norm_ffn_g(); float* rs2 = T_RS2(); unsigned char* H8 = T_H8(); unsigned char* X18 = T_X1I8();
      const float h6s = T_SCALES()[1];
      for (int m = gw; m < M; m += NGW) rms_rowb_to_h2(x1 + (size_t)m * DM, g, rs2 + m, H8, m, F.lane, X18 + (size_t)m * DM, h6s); }
    GRID_BAR();
    {
        pg8::Gemm g{(const bf16*)T_X1I8(), (const bf16*)T_WSC8(), M, PQ, DM / 2}; pg8::StaticOrder S; S.init(M, PQ, F.G, F.cid);
        pg8::EpiF32PlainI8 E{T_SC(), PQ, T_RS2(), T_CMAXW()};
        pg8::gemm_phase<pg8::EpiF32PlainI8, pg8::StaticOrder, true, true, 2>(F.lds + RING_OFF, g, S, E, F.wave);
#if defined(HY_PROBE_P5A)
        __syncthreads(); pg8::gemm_phase<pg8::EpiF32Plain, pg8::StaticOrder, true, true>(F.lds + RING_OFF, g, S, E, F.wave);
#endif
    }
    GRID_BAR();
    p5_topk_phase(F);
#if defined(HY_PROBE_P5)
    GRID_BAR(); p5_topk_phase(F); GRID_BAR(); p5_topk_phase(F); GRID_BAR(); p5_topk_phase(F);
#endif
    GRID_BAR();
    {
        pg8::Gemm g{(const bf16*)T_H8(), (const bf16*)T_WD8(), M, NEXP, DM / 2}; pg8::StaticOrder S; S.init(M, NEXP, F.G, F.cid);
        pg8::EpiGeluGate8 E{T_G8(), NEXP, 1.0f / (T_SCALES()[1] * T_SCALES()[0])};
#if defined(HY_PROBE_P6)
        { pg8::EpiNull EN; pg8::gemm_phase<pg8::EpiNull, pg8::StaticOrder, true, true, 1>(F.lds + RING_OFF, g, S, EN, F.wave); __syncthreads(); }
#endif
        pg8::gemm_phase_fp6p<pg8::EpiGeluGate8, pg8::StaticOrder>(F.lds + RING_OFF, T_H8(), T_WD8(), S, E, F.wave);
    }
    GRID_BAR();
    {
        pg8::Gemm g{(const bf16*)T_G8(), (const bf16*)T_WUP8(), M, DM, NEXP / 2}; pg8::StaticOrder S; S.init(M, DM, F.G, F.cid);
        pg8::EpiResBf16 E{T_X1B(), T_X2B(), DM, 1.0f / (G_SCALE * T_SCALES()[2]), nullptr};
#if defined(HY_PROBE_P7)
        { pg8::EpiNull EN; pg8::gemm_phase<pg8::EpiNull, pg8::StaticOrder, true, true, 1>(F.lds + RING_OFF, g, S, EN, F.wave); __syncthreads(); }
#endif
#if defined(HY_PROBE_P7L2)
        { struct SameTile : pg8::StaticOrder { __device__ bool next(int i, pg8::Unit& u) const { pg8::Unit t; const bool ok = pg8::StaticOrder::next(i, t); u.pm = 0; u.pn = 0; return ok; } } S2; S2.init(M, DM, F.G, F.cid);
          pg8::EpiNull EN; pg8::gemm_phase<pg8::EpiNull, SameTile, true, true, 1>(F.lds + RING_OFF, g, S2, EN, F.wave); __syncthreads(); }
#endif
        pg8::gemm_phase<pg8::EpiResBf16, pg8::StaticOrder, true, true, 1>(F.lds + RING_OFF, g, S, E, F.wave);
    }
    GRID_BAR();
    }
    if (nph > 5) { const bf16* x2 = T_X2B(); float* o_ = kout(); const float* g = T_norm_final_g();
      p8_rows(x2, g, o_, gw, NGW, M / NGW, F.lane); }
#undef GRID_BAR
}


#ifndef HY_NPHASE
#define HY_NPHASE 9
#endif
extern "C" void kernel_launch(void* const* d_in, const int* in_sizes, int n_in, void* d_out, int out_size, void* d_ws, size_t ws_size, hipStream_t stream) {
    static int grid = 0;
    if (grid == 0) {
        if (n_in != 15 || in_sizes[0] != M * DM || out_size != M * DM || ws_size < WS_END) {
            fprintf(stderr, "kernel_launch: built for 15 inputs, x/out of %d floats, >= %zu bytes of workspace; got n_in %d, in0 %d, out %d, ws %zu; nothing launched\n", M * DM, (size_t)WS_END, n_in, n_in > 0 ? in_sizes[0] : -1, out_size, ws_size);
            grid = -1; return; }
        int dev = 0, cus = 0, per_cu = 0;
        if (hipGetDevice(&dev) != hipSuccess || hipDeviceGetAttribute(&cus, hipDeviceAttributeMultiprocessorCount, dev) != hipSuccess) { fprintf(stderr, "kernel_launch: device query failed\n"); grid = -1; return; }
        if (hipFuncSetAttribute((const void*)hymba_fwd, hipFuncAttributeMaxDynamicSharedMemorySize, LDS_BYTES) != hipSuccess) { fprintf(stderr, "kernel_launch: hipFuncSetAttribute failed\n"); grid = -1; return; }
        if (hipOccupancyMaxActiveBlocksPerMultiprocessor(&per_cu, (const void*)hymba_fwd, NWAVES * 64, LDS_BYTES) != hipSuccess || per_cu < 1)
            fprintf(stderr, "kernel_launch: note: occupancy query reports %d workgroups per CU\n", per_cu);
        (void)hipGetLastError();
        if (cus < 256) { fprintf(stderr, "kernel_launch: built for a 256-CU device (one workgroup per CU, all resident); this one reports %d; nothing launched\n", cus); grid = -1; return; }
        grid = 256;
    }
    if (grid < 0) return;
    if (hipMemsetAsync((char*)d_ws + WS_CTL, 0, CTL_ZERO_BYTES, stream) != hipSuccess) { fprintf(stderr, "kernel_launch: hipMemsetAsync failed\n"); return; }
    Args a{};
    for (int i = 0; i < 15; ++i) a.in[i] = (const float*)d_in[i];
    a.out = (float*)d_out; a.ws = (unsigned char*)d_ws; a.nphase = HY_NPHASE; a.pad = 0;
    hipLaunchKernelGGL(hymba_fwd, dim3(grid), dim3(NWAVES * 64), LDS_BYTES, stream, a);
    const hipError_t le = hipPeekAtLastError();
    if (le != hipSuccess) fprintf(stderr, "kernel_launch: launch failed: %s\n", hipGetErrorName(le));
}
```

```cpp
#include <hip/hip_runtime.h>
#include <hip/hip_bf16.h>
#include <cstdio>
#include <cstdint>
namespace pg8 {
#define PG8_LAS __attribute__((address_space(3)))
typedef unsigned short bf16_t;
typedef short bf16x8 __attribute__((ext_vector_type(8)));
typedef float f32x4 __attribute__((ext_vector_type(4)));
typedef unsigned u32x4 __attribute__((ext_vector_type(4)));
typedef int i32x4 __attribute__((ext_vector_type(4)));
typedef int i32x8 __attribute__((ext_vector_type(8)));
typedef int i32x6 __attribute__((ext_vector_type(6)));
typedef int i32x2 __attribute__((ext_vector_type(2)));
typedef float f32x16v __attribute__((ext_vector_type(16)));
typedef unsigned u32x2 __attribute__((ext_vector_type(2)));
constexpr int BM = 256, BK = 64, HALF = 128, HTB = HALF * BK * 2  , STAGE_BYTES = 8 * HTB, NXCD = 8, WGM = 8;

__host__ __device__ __forceinline__ int lds_byte(int r, int c) { const int st = (r >> 4) * 2 + (c >> 5), rr = r & 15, cc = c & 31, ob = rr * 64 + cc * 2; return st * 1024 + (ob ^ (((ob >> 9) & 1) << 5)); }
__host__ __device__ __forceinline__ void stage_rc(int b, int& R, int& C) { const int st = b / 1024, sb = b % 1024, swz = sb ^ (((sb >> 9) & 1) << 5); R = (st >> 1) * 16 + swz / 64; C = (st & 1) * 32 + (swz % 64) / 2; }
__host__ __device__ __forceinline__ int perm32(int rho) { const int n = rho >> 4, i = rho & 15; return 8 * (i >> 2) + 4 * n + (i & 3); }

struct Unit { int pm, pn; };
struct Gemm { const bf16_t* A; const bf16_t* Bt; int M, N, K; };

struct StaticOrder {
    int nM, nN, nwg, G, c;
    __host__ __device__ void init(int M, int N, int G_, int c_) { nM = M / BM; nN = N / BM; nwg = nM * nN; G = G_; c = c_; }
    __host__ __device__ bool next(int i, Unit& u) const {
        const long L = (long)i * G + c; if (L >= nwg) return false;
        int wgid = (int)L; { const int q = nwg / NXCD, r = nwg % NXCD, xcd = wgid % NXCD, off = wgid / NXCD; wgid = (xcd < r ? xcd * (q + 1) : r * (q + 1) + (xcd - r) * q) + off; }
        const int nig = WGM * nN, gid = wgid / nig, fm = gid * WGM, gsz = (nM - fm) < WGM ? (nM - fm) : WGM;
        u.pm = fm + ((wgid % nig) % gsz); u.pn = (wgid % nig) / gsz; return true;
    }
    __device__ __forceinline__ void a_ready(const Unit&) const {}
    __device__ __forceinline__ void done(const Unit&) const {}
};

__device__ __forceinline__ unsigned cvt_pk_bf16(float lo, float hi) { unsigned r; asm volatile("v_cvt_pk_bf16_f32 %0, %1, %2" : "=v"(r) : "v"(lo), "v"(hi)); return r; }
typedef float f32x2 __attribute__((ext_vector_type(2)));
__device__ __forceinline__ f32x2 gelu_pk(f32x2 v) {
    const f32x2 av = __builtin_elementwise_abs(v), d = av * 0.2316418882f + 1.0f;
    f32x2 t; t.x = __builtin_amdgcn_rcpf(d.x); t.y = __builtin_amdgcn_rcpf(d.y);
    f32x2 q = t * 0.5307027145f + (-0.7265760135f); q = q * t + 0.7107068705f; q = q * t + (-0.142248368f); q = q * t + 0.127414796f; q = q * t;
    const f32x2 s = (v * v) * (-0.72134752044f);
    f32x2 e; e.x = __builtin_amdgcn_exp2f(s.x); e.y = __builtin_amdgcn_exp2f(s.y);
    const f32x2 m = v * (q * e), r = v - m;
    f32x2 o; o.x = v.x < 0.f ? m.x : r.x; o.y = v.y < 0.f ? m.y : r.y; return o;
}

template <int ACT  > struct EpiBf16 {
    static constexpr bool PERM = true, AFTER_DRAIN = false; static_assert(ACT == 0 || ACT == 1, "EpiBf16: ACT is 0 (none) or 1 (gelu_pk)");
    bf16_t* O; int ldc; const float* bias; int split_cols; size_t split_stride; float scale0;
    __device__ __forceinline__ void operator()(const f32x4 (&acc)[2][2][4][2], const Unit& u, int wr, int wc, int fr, int fq) const {
        const int row0 = u.pm * BM + wr * 64 + fr; int colt = u.pn * BM; bf16_t* base = O;
        float sc = 1.f; if (split_cols) { const int t = colt / split_cols; base += (size_t)t * split_stride; colt -= t * split_cols; if (t == 0) sc = scale0; }
        const int col0 = colt + wc * 32 + 8 * fq, bcol0 = u.pn * BM + wc * 32 + 8 * fq;
        f32x4 bv[2][2];
#pragma unroll
        for (int bj = 0; bj < 2; ++bj)
#pragma unroll
            for (int n = 0; n < 2; ++n) bv[bj][n] = bias ? *(const f32x4*)(bias + bcol0 + bj * HALF + 4 * n) : (f32x4){0.f, 0.f, 0.f, 0.f};
#pragma unroll
        for (int ai = 0; ai < 2; ++ai)
#pragma unroll
            for (int m = 0; m < 4; ++m) { bf16_t* rowp = base + (size_t)(row0 + ai * HALF + m * 16) * ldc + col0;
#pragma unroll
                for (int bj = 0; bj < 2; ++bj) { f32x4 v0 = acc[ai][bj][m][0] + bv[bj][0], v1 = acc[ai][bj][m][1] + bv[bj][1];
                    if (ACT == 1) { f32x2 a = gelu_pk((f32x2){v0[0], v0[1]}), b = gelu_pk((f32x2){v0[2], v0[3]}), c = gelu_pk((f32x2){v1[0], v1[1]}), d = gelu_pk((f32x2){v1[2], v1[3]});
                        v0 = (f32x4){a.x, a.y, b.x, b.y}; v1 = (f32x4){c.x, c.y, d.x, d.y}; }
                    v0 = v0 * sc; v1 = v1 * sc; u32x4 w; w.x = cvt_pk_bf16(v0[0], v0[1]); w.y = cvt_pk_bf16(v0[2], v0[3]); w.z = cvt_pk_bf16(v1[0], v1[1]); w.w = cvt_pk_bf16(v1[2], v1[3]);
                    *(u32x4*)(rowp + bj * HALF) = w; } }
    }
};
struct EpiResF32 {
    static constexpr bool PERM = false, AFTER_DRAIN = false;
    const float* base; float* out; int ldc; float scale;
    __device__ __forceinline__ void operator()(const f32x4 (&acc)[2][2][4][2], const Unit& u, int wr, int wc, int fr, int fq) const {
        const int row0 = u.pm * BM + wr * 64 + fr, col0 = u.pn * BM + wc * 32 + 4 * fq;
#pragma unroll
        for (int ai = 0; ai < 2; ++ai)
#pragma unroll
            for (int m = 0; m < 4; ++m) { const size_t off = (size_t)(row0 + ai * HALF + m * 16) * ldc + col0;
                f32x4 b[2][2];
#pragma unroll
                for (int bj = 0; bj < 2; ++bj)
#pragma unroll
                    for (int n = 0; n < 2; ++n) b[bj][n] = *(const f32x4*)(base + off + bj * HALF + n * 16);
#pragma unroll
                for (int bj = 0; bj < 2; ++bj)
#pragma unroll
                    for (int n = 0; n < 2; ++n) *(f32x4*)(out + off + bj * HALF + n * 16) = b[bj][n] + acc[ai][bj][m][n] * scale;
                if (m & 1) asm volatile("" ::: "memory"); }
    }
};
struct EpiF32Plain {
    static constexpr bool PERM = false, AFTER_DRAIN = false;
    float* C; int ldc; const float* rowfac;
    __device__ __forceinline__ void operator()(const f32x4 (&acc)[2][2][4][2], const Unit& u, int wr, int wc, int fr, int fq) const {
        const int row0 = u.pm * BM + wr * 64 + fr, col0 = u.pn * BM + wc * 32 + 4 * fq;
#pragma unroll
        for (int ai = 0; ai < 2; ++ai)
#pragma unroll
            for (int m = 0; m < 4; ++m) { const int row = row0 + ai * HALF + m * 16; const float rf = rowfac[row]; float* rowp = C + (size_t)row * ldc + col0;
#pragma unroll
                for (int bj = 0; bj < 2; ++bj)
#pragma unroll
                    for (int n = 0; n < 2; ++n) *(f32x4*)(rowp + bj * HALF + n * 16) = acc[ai][bj][m][n] * rf; }
    }
};
struct EpiF32PlainI8 {
    static constexpr bool PERM = false, AFTER_DRAIN = false;
    float* C; int ldc; const float* rowfac; const float* colmax;
    __device__ __forceinline__ void operator()(const f32x4 (&acc)[2][2][4][2], const Unit& u, int wr, int wc, int fr, int fq) const {
        const int row0 = u.pm * BM + wr * 64 + fr, col0 = u.pn * BM + wc * 32 + 4 * fq;
        f32x4 cs[2][2];
#pragma unroll
        for (int bj = 0; bj < 2; ++bj)
#pragma unroll
            for (int n = 0; n < 2; ++n) cs[bj][n] = *(const f32x4*)(colmax + col0 + bj * HALF + n * 16) * (1.f / 127.f);
#pragma unroll
        for (int ai = 0; ai < 2; ++ai)
#pragma unroll
            for (int m = 0; m < 4; ++m) { const int row = row0 + ai * HALF + m * 16; const float rf = rowfac[row]; float* rowp = C + (size_t)row * ldc + col0;
#pragma unroll
                for (int bj = 0; bj < 2; ++bj)
#pragma unroll
                    for (int n = 0; n < 2; ++n) { const i32x4 iv = __builtin_bit_cast(i32x4, acc[ai][bj][m][n]); const f32x4 c = cs[bj][n] * rf;
                        *(f32x4*)(rowp + bj * HALF + n * 16) = (f32x4){(float)iv[0] * c[0], (float)iv[1] * c[1], (float)iv[2] * c[2], (float)iv[3] * c[3]}; } }
    }
};
struct EpiGeluGate {
    static constexpr bool PERM = true, AFTER_DRAIN = false;
    bf16_t* G; int ldc;
    __device__ __forceinline__ void operator()(const f32x4 (&acc)[2][2][4][2], const Unit& u, int wr, int wc, int fr, int fq) const {
        const int row0 = u.pm * BM + wr * 64 + fr, col0 = u.pn * BM + wc * 32 + 8 * fq;
#pragma unroll
        for (int ai = 0; ai < 2; ++ai) {
            u32x4 g[4][2];
#pragma unroll
            for (int m = 0; m < 4; ++m)
#pragma unroll
                for (int bj = 0; bj < 2; ++bj) g[m][bj] = *(const u32x4*)(G + (size_t)(row0 + ai * HALF + m * 16) * ldc + col0 + bj * HALF);
#pragma unroll
            for (int m = 0; m < 4; ++m)
#pragma unroll
                for (int bj = 0; bj < 2; ++bj) { const u32x4 gw = g[m][bj];
                    if ((gw.x | gw.y | gw.z | gw.w) != 0u) {
                        const f32x4 v0 = acc[ai][bj][m][0], v1 = acc[ai][bj][m][1];
                        const f32x2 a = gelu_pk((f32x2){v0[0], v0[1]}), b = gelu_pk((f32x2){v0[2], v0[3]}), c = gelu_pk((f32x2){v1[0], v1[1]}), d = gelu_pk((f32x2){v1[2], v1[3]});
                        u32x4 w;
                        w.x = cvt_pk_bf16(a.x * __uint_as_float(gw.x << 16), a.y * __uint_as_float(gw.x & 0xffff0000u));
                        w.y = cvt_pk_bf16(b.x * __uint_as_float(gw.y << 16), b.y * __uint_as_float(gw.y & 0xffff0000u));
                        w.z = cvt_pk_bf16(c.x * __uint_as_float(gw.z << 16), c.y * __uint_as_float(gw.z & 0xffff0000u));
                        w.w = cvt_pk_bf16(d.x * __uint_as_float(gw.w << 16), d.y * __uint_as_float(gw.w & 0xffff0000u));
                        *(u32x4*)(G + (size_t)(row0 + ai * HALF + m * 16) * ldc + col0 + bj * HALF) = w; } }
        }
    }
};
__device__ __forceinline__ unsigned pk4_fp8(float a, float b, float c, float d) {
    a = __builtin_fminf(__builtin_fmaxf(a, -448.f), 448.f); b = __builtin_fminf(__builtin_fmaxf(b, -448.f), 448.f); c = __builtin_fminf(__builtin_fmaxf(c, -448.f), 448.f); d = __builtin_fminf(__builtin_fmaxf(d, -448.f), 448.f);
    int w = 0; w = __builtin_amdgcn_cvt_pk_fp8_f32(a, b, w, false); w = __builtin_amdgcn_cvt_pk_fp8_f32(c, d, w, true); return (unsigned)w; }
struct EpiGeluGate8 {
    static constexpr bool PERM = true, AFTER_DRAIN = false;
    unsigned char* G; int ldc; float uscale;
    __device__ __forceinline__ void operator()(const f32x4 (&acc)[2][2][4][2], const Unit& u, int wr, int wc, int fr, int fq) const {
        const int row0 = u.pm * BM + wr * 64 + fr, col0 = u.pn * BM + wc * 32 + 8 * fq;
#pragma unroll
        for (int ai = 0; ai < 2; ++ai) {
            u32x2 g[4][2];
#pragma unroll
            for (int m = 0; m < 4; ++m)
#pragma unroll
                for (int bj = 0; bj < 2; ++bj) g[m][bj] = *(const u32x2*)(G + (size_t)(row0 + ai * HALF + m * 16) * ldc + col0 + bj * HALF);
#pragma unroll
            for (int m = 0; m < 4; ++m)
#pragma unroll
                for (int bj = 0; bj < 2; ++bj) { const u32x2 gw = g[m][bj];
                    if ((gw.x | gw.y) != 0u) {
                        const f32x4 v0 = acc[ai][bj][m][0] * uscale, v1 = acc[ai][bj][m][1] * uscale;
                        const f32x2 a = gelu_pk((f32x2){v0[0], v0[1]}), b = gelu_pk((f32x2){v0[2], v0[3]}), c = gelu_pk((f32x2){v1[0], v1[1]}), d = gelu_pk((f32x2){v1[2], v1[3]});
                        u32x2 w;
                        w.x = pk4_fp8(a.x * __builtin_amdgcn_cvt_f32_fp8((int)gw.x, 0), a.y * __builtin_amdgcn_cvt_f32_fp8((int)gw.x, 1), b.x * __builtin_amdgcn_cvt_f32_fp8((int)gw.x, 2), b.y * __builtin_amdgcn_cvt_f32_fp8((int)gw.x, 3));
                        w.y = pk4_fp8(c.x * __builtin_amdgcn_cvt_f32_fp8((int)gw.y, 0), c.y * __builtin_amdgcn_cvt_f32_fp8((int)gw.y, 1), d.x * __builtin_amdgcn_cvt_f32_fp8((int)gw.y, 2), d.y * __builtin_amdgcn_cvt_f32_fp8((int)gw.y, 3));
                        *(u32x2*)(G + (size_t)(row0 + ai * HALF + m * 16) * ldc + col0 + bj * HALF) = w; } }
        }
    }
};
struct EpiBf16I8 {
    static constexpr bool PERM = true, AFTER_DRAIN = false;
    bf16_t* O; int ldc; const float* rowscale; const float* colmax;
    __device__ __forceinline__ void operator()(const f32x4 (&acc)[2][2][4][2], const Unit& u, int wr, int wc, int fr, int fq) const {
        const int row0 = u.pm * BM + wr * 64 + fr, col0 = u.pn * BM + wc * 32 + 8 * fq;
        f32x4 cs[2][2];
#pragma unroll
        for (int bj = 0; bj < 2; ++bj)
#pragma unroll
            for (int n = 0; n < 2; ++n) cs[bj][n] = *(const f32x4*)(colmax + col0 + bj * HALF + 4 * n) * (1.f / 127.f);
#pragma unroll
        for (int ai = 0; ai < 2; ++ai)
#pragma unroll
            for (int m = 0; m < 4; ++m) { const int row = row0 + ai * HALF + m * 16; const float sc = rowscale[row]; bf16_t* rowp = O + (size_t)row * ldc + col0;
#pragma unroll
                for (int bj = 0; bj < 2; ++bj) { const i32x4 i0 = __builtin_bit_cast(i32x4, acc[ai][bj][m][0]), i1 = __builtin_bit_cast(i32x4, acc[ai][bj][m][1]); const f32x4 c0 = cs[bj][0] * sc, c1 = cs[bj][1] * sc;
                    u32x4 w; w.x = cvt_pk_bf16((float)i0[0] * c0[0], (float)i0[1] * c0[1]); w.y = cvt_pk_bf16((float)i0[2] * c0[2], (float)i0[3] * c0[3]); w.z = cvt_pk_bf16((float)i1[0] * c1[0], (float)i1[1] * c1[1]); w.w = cvt_pk_bf16((float)i1[2] * c1[2], (float)i1[3] * c1[3]);
                    *(u32x4*)(rowp + bj * HALF) = w; } }
    }
};
struct EpiResBf16I8 {
    static constexpr bool PERM = true, AFTER_DRAIN = false;
    static constexpr int MIDK_TAB = 147456 + 8192;
    const bf16_t* base; bf16_t* out; int ldc; const float* rowscale; const float* colmax;
    const float* rho;
    __device__ __forceinline__ void midk_pre(const Unit& u, PG8_LAS unsigned char* lds, int wid) const {
        unsigned z_ = 0u; asm volatile("" : "+v"(z_)); const int tid = (wid << 6) | (int)__builtin_amdgcn_mbcnt_hi(~0u, __builtin_amdgcn_mbcnt_lo(~0u, z_));
        if (tid < BM) ((PG8_LAS float*)(lds + MIDK_TAB))[tid] = rho[u.pm * BM + tid];
    }
    __device__ __forceinline__ void midk(f32x4 (&acc)[2][2][4][2], PG8_LAS unsigned char* lds, int wr, int fr) const {
        const PG8_LAS float* tab = (const PG8_LAS float*)(lds + MIDK_TAB) + wr * 64 + fr;
#pragma unroll
        for (int ai = 0; ai < 2; ++ai)
#pragma unroll
            for (int m = 0; m < 4; ++m) { const float f = tab[ai * HALF + m * 16];
#pragma unroll
                for (int bj = 0; bj < 2; ++bj)
#pragma unroll
                    for (int n = 0; n < 2; ++n) { const i32x4 iv = __builtin_bit_cast(i32x4, acc[ai][bj][m][n]);
                        const i32x4 o = {(int)__builtin_rintf((float)iv[0] * f), (int)__builtin_rintf((float)iv[1] * f), (int)__builtin_rintf((float)iv[2] * f), (int)__builtin_rintf((float)iv[3] * f)};
                        acc[ai][bj][m][n] = __builtin_bit_cast(f32x4, o); } }
    }
    __device__ __forceinline__ void operator()(const f32x4 (&acc)[2][2][4][2], const Unit& u, int wr, int wc, int fr, int fq) const {
        const int row0 = u.pm * BM + wr * 64 + fr, col0 = u.pn * BM + wc * 32 + 8 * fq;
        f32x4 cs[2][2];
#pragma unroll
        for (int bj = 0; bj < 2; ++bj)
#pragma unroll
            for (int n = 0; n < 2; ++n) cs[bj][n] = *(const f32x4*)(colmax + col0 + bj * HALF + 4 * n) * (1.f / 127.f);
#pragma unroll
        for (int ai = 0; ai < 2; ++ai) {
            u32x4 b[4][2];
#pragma unroll
            for (int m = 0; m < 4; ++m)
#pragma unroll
                for (int bj = 0; bj < 2; ++bj) b[m][bj] = *(const u32x4*)(base + (size_t)(row0 + ai * HALF + m * 16) * ldc + col0 + bj * HALF);
#pragma unroll
            for (int m = 0; m < 4; ++m) { const int row = row0 + ai * HALF + m * 16; const float sc = rowscale[row];
#pragma unroll
                for (int bj = 0; bj < 2; ++bj) { const u32x4 bw = b[m][bj]; const i32x4 i0 = __builtin_bit_cast(i32x4, acc[ai][bj][m][0]), i1 = __builtin_bit_cast(i32x4, acc[ai][bj][m][1]); const f32x4 c0 = cs[bj][0] * sc, c1 = cs[bj][1] * sc;
                    u32x4 w;
                    w.x = cvt_pk_bf16(__uint_as_float(bw.x << 16) + (float)i0[0] * c0[0], __uint_as_float(bw.x & 0xffff0000u) + (float)i0[1] * c0[1]); w.y = cvt_pk_bf16(__uint_as_float(bw.y << 16) + (float)i0[2] * c0[2], __uint_as_float(bw.y & 0xffff0000u) + (float)i0[3] * c0[3]);
                    w.z = cvt_pk_bf16(__uint_as_float(bw.z << 16) + (float)i1[0] * c1[0], __uint_as_float(bw.z & 0xffff0000u) + (float)i1[1] * c1[1]); w.w = cvt_pk_bf16(__uint_as_float(bw.w << 16) + (float)i1[2] * c1[2], __uint_as_float(bw.w & 0xffff0000u) + (float)i1[3] * c1[3]);
                    *(u32x4*)(out + (size_t)row * ldc + col0 + bj * HALF) = w; } }
        }
    }
};
struct EpiResBf16 {
    static constexpr bool PERM = true, AFTER_DRAIN = false;
    static constexpr int MIDK_TAB = 147456 + 8192;
    const bf16_t* base; bf16_t* out; int ldc; float scale;
    const float* rss;
    __device__ __forceinline__ void midk_pre(const Unit& u, PG8_LAS unsigned char* lds, int wid) const {
        unsigned z_ = 0u; asm volatile("" : "+v"(z_)); const int tid = (wid << 6) | (int)__builtin_amdgcn_mbcnt_hi(~0u, __builtin_amdgcn_mbcnt_lo(~0u, z_));
        const int rl = tid >> 1; const f32x4* p = (const f32x4*)(rss + ((size_t)(u.pm * BM + rl) * 16 + (tid & 1) * 8));
        const f32x4 a = p[0], b = p[1]; float s = ((a[0] + a[1]) + (a[2] + a[3])) + ((b[0] + b[1]) + (b[2] + b[3]));
        s += __int_as_float(__builtin_amdgcn_ds_swizzle(__float_as_int(s), 0x041F));
        ((PG8_LAS float*)(lds + MIDK_TAB))[rl] = 1.0f / sqrtf(s * (1.f / 2048.f) + 1e-6f);
    }
    __device__ __forceinline__ void midk(f32x4 (&acc)[2][2][4][2], PG8_LAS unsigned char* lds, int wr, int fr) const {
        const PG8_LAS float* tab = (const PG8_LAS float*)(lds + MIDK_TAB) + wr * 64 + fr;
#pragma unroll
        for (int ai = 0; ai < 2; ++ai)
#pragma unroll
            for (int m = 0; m < 4; ++m) { const float f = tab[ai * HALF + m * 16];
#pragma unroll
                for (int bj = 0; bj < 2; ++bj)
#pragma unroll
                    for (int n = 0; n < 2; ++n) acc[ai][bj][m][n] = acc[ai][bj][m][n] * f; }
    }
    __device__ __forceinline__ void operator()(const f32x4 (&acc)[2][2][4][2], const Unit& u, int wr, int wc, int fr, int fq) const {
        const int row0 = u.pm * BM + wr * 64 + fr, col0 = u.pn * BM + wc * 32 + 8 * fq;
#pragma unroll
        for (int ai = 0; ai < 2; ++ai) {
            u32x4 b[4][2];
#pragma unroll
            for (int m = 0; m < 4; ++m)
#pragma unroll
                for (int bj = 0; bj < 2; ++bj) b[m][bj] = *(const u32x4*)(base + (size_t)(row0 + ai * HALF + m * 16) * ldc + col0 + bj * HALF);
#pragma unroll
            for (int m = 0; m < 4; ++m)
#pragma unroll
                for (int bj = 0; bj < 2; ++bj) { const u32x4 bw = b[m][bj]; const f32x4 v0 = acc[ai][bj][m][0] * scale, v1 = acc[ai][bj][m][1] * scale;
                    u32x4 w;
                    w.x = cvt_pk_bf16(__uint_as_float(bw.x << 16) + v0[0], __uint_as_float(bw.x & 0xffff0000u) + v0[1]); w.y = cvt_pk_bf16(__uint_as_float(bw.y << 16) + v0[2], __uint_as_float(bw.y & 0xffff0000u) + v0[3]);
                    w.z = cvt_pk_bf16(__uint_as_float(bw.z << 16) + v1[0], __uint_as_float(bw.z & 0xffff0000u) + v1[1]); w.w = cvt_pk_bf16(__uint_as_float(bw.w << 16) + v1[2], __uint_as_float(bw.w & 0xffff0000u) + v1[3]);
                    *(u32x4*)(out + (size_t)(row0 + ai * HALF + m * 16) * ldc + col0 + bj * HALF) = w; }
        }
    }
};
template <int NS> struct SideZero {
    static constexpr bool ACTIVE = true;
    unsigned char* slice;
    __device__ __forceinline__ void tick(int k, int tid) const {
        u32x4 z = {0u, 0u, 0u, 0u}; asm volatile("" : "+v"(z));
        unsigned char* p = slice + (size_t)k * (8192 * NS) + tid * 16;
#pragma unroll
        for (int i = 0; i < NS; ++i) *(u32x4*)(p + i * 8192) = z;
    }
};
struct EpiNull {
    static constexpr bool PERM = true, AFTER_DRAIN = false;
    __device__ __forceinline__ void operator()(const f32x4 (&acc)[2][2][4][2], const Unit& u, int wr, int wc, int fr, int fq) const { asm volatile("" :: "v"(acc[0][0][0][0]), "v"(acc[1][1][3][1])); }
};
__device__ __forceinline__ i32x6 pg8_cat6(const i32x4 lo, const i32x2 hi) { const i32x4 h4 = __builtin_shufflevector(hi, hi, 0, 1, -1, -1); return __builtin_shufflevector(lo, h4, 0, 1, 2, 3, 4, 5); }
struct NoSide { static constexpr bool ACTIVE = false; __device__ __forceinline__ void tick(int, int) const {} };
template <class Epi, class Sched, bool ALIGN_EPI = false, bool SP2 = false, int MODE = 0, bool MIDK = false, class Side = NoSide>
__device__ __forceinline__ void gemm_phase(PG8_LAS unsigned char* lds, const Gemm g, const Sched& S, const Epi& E, const int wave_id  , const Side SD = Side()) {
    constexpr bool FP6 = (MODE == 3), FP8 = (MODE == 1) || FP6, I8 = (MODE == 2);
    unsigned z_ = 0u; asm volatile("" : "+v"(z_)); const int tid_ = (wave_id << 6) | (int)__builtin_amdgcn_mbcnt_hi(~0u, __builtin_amdgcn_mbcnt_lo(~0u, z_));
    const int tid = tid_, wid = __builtin_amdgcn_readfirstlane(tid >> 6), lane = tid & 63, wr = wid >> 2, wc = wid & 3, fr = lane & 15, fq = lane >> 4;
    const int K = g.K, nt = K / BK;
    unsigned voffA[2], voffB[2];
#pragma unroll
    for (int i = 0; i < 2; ++i) { int R, C; stage_rc(tid * 16 + i * 8192, R, C); const int Rb = Epi::PERM ? ((R & ~31) + perm32(R & 31)) : R;
        voffA[i] = (unsigned)(R * K + C) * 2u; voffB[i] = (unsigned)(Rb * K + C) * 2u; }
    const size_t kstep = (size_t)(BK * 2);
    const size_t hstep = (size_t)HALF * K * 2;
    const size_t tstep = 2 * hstep;
    const unsigned ldsw = (unsigned)wid * 1024u;
    const int aoff = lds_byte(wr * 64 + fr, fq * 8), boff = lds_byte(wc * 32 + fr, fq * 8);
#define PG8_SA(b, h) (((b) * 2 + (h)) * HTB)
#define PG8_SB(b, h) ((4 + (b) * 2 + (h)) * HTB)
#define PG8_STAGE(bufoff, gbase, voff) do { _Pragma("unroll") for (int _i = 0; _i < 2; ++_i) \
        __builtin_amdgcn_global_load_lds((const unsigned*)((const char*)(gbase) + (voff)[_i]), (PG8_LAS unsigned*)(lds + (bufoff) + ldsw + _i * 8192), 16, 0, 0); } while (0)
#define PG8_CAT(lo, hi) __builtin_shufflevector(lo, hi, 0, 1, 2, 3, 4, 5, 6, 7)
#define PG8_CAT6(lo, hi2) pg8_cat6(lo, hi2)
#define PG8_LDA(dst, b, h) do { if constexpr (FP6) { _Pragma("unroll") for (int m = 0; m < 4; ++m) dst##6[m] = PG8_CAT6(*(const PG8_LAS i32x4*)(lds + PG8_SA(b, h) + aoff + m * 2048), *(const volatile PG8_LAS i32x2*)(lds + PG8_SA(b, h) + aoff + m * 2048 + 1024)); } \
        else if constexpr (FP8) { _Pragma("unroll") for (int m = 0; m < 4; ++m) dst##8[m] = PG8_CAT(*(const PG8_LAS i32x4*)(lds + PG8_SA(b, h) + aoff + m * 2048), *(const PG8_LAS i32x4*)(lds + PG8_SA(b, h) + aoff + m * 2048 + 1024)); } \
        else { _Pragma("unroll") for (int m = 0; m < 4; ++m) _Pragma("unroll") for (int k = 0; k < 2; ++k) dst[m][k] = *(const PG8_LAS bf16x8*)(lds + PG8_SA(b, h) + aoff + m * 2048 + k * 1024); } } while (0)
#define PG8_LDB(dst, b, h) do { if constexpr (FP6) { _Pragma("unroll") for (int n = 0; n < 2; ++n) dst##6[n] = PG8_CAT6(*(const PG8_LAS i32x4*)(lds + PG8_SB(b, h) + boff + n * 2048), *(const volatile PG8_LAS i32x2*)(lds + PG8_SB(b, h) + boff + n * 2048 + 1024)); } \
        else if constexpr (FP8) { _Pragma("unroll") for (int n = 0; n < 2; ++n) dst##8[n] = PG8_CAT(*(const PG8_LAS i32x4*)(lds + PG8_SB(b, h) + boff + n * 2048), *(const PG8_LAS i32x4*)(lds + PG8_SB(b, h) + boff + n * 2048 + 1024)); } \
        else { _Pragma("unroll") for (int n = 0; n < 2; ++n) _Pragma("unroll") for (int k = 0; k < 2; ++k) dst[n][k] = *(const PG8_LAS bf16x8*)(lds + PG8_SB(b, h) + boff + n * 2048 + k * 1024); } } while (0)
#define PG8_MMA(ai, bj, At, Bt) do { __builtin_amdgcn_s_setprio(1); if constexpr (FP8) asm volatile("s_nop 4" ::: "memory"); _Pragma("unroll") for (int m = 0; m < 4; ++m) _Pragma("unroll") for (int n = 0; n < 2; ++n) { \
        if constexpr (FP6) asm volatile("v_mfma_scale_f32_16x16x128_f8f6f4 %0, %1, %2, %0, %3, %3 op_sel_hi:[0,0,0] cbsz:2 blgp:2" : "+v"(acc[ai][bj][m][n]) : "v"(Bt##6[n]), "v"(At##6[m]), "v"(scl1)); \
        else if constexpr (FP8) asm volatile("v_mfma_scale_f32_16x16x128_f8f6f4 %0, %1, %2, %0, %3, %3 op_sel_hi:[0,0,0]" : "+v"(acc[ai][bj][m][n]) : "v"(Bt##8[n]), "v"(At##8[m]), "v"(scl1));   \
        else if constexpr (I8) { _Pragma("unroll") for (int k = 0; k < 2; ++k) acc[ai][bj][m][n] = __builtin_bit_cast(f32x4, __builtin_amdgcn_mfma_i32_16x16x64_i8(__builtin_bit_cast(i32x4, Bt[n][k]), __builtin_bit_cast(i32x4, At[m][k]), __builtin_bit_cast(i32x4, acc[ai][bj][m][n]), 0, 0, 0)); } \
        else { _Pragma("unroll") for (int k = 0; k < 2; ++k) acc[ai][bj][m][n] = __builtin_amdgcn_mfma_f32_16x16x32_bf16(Bt[n][k], At[m][k], acc[ai][bj][m][n], 0, 0, 0); } } __builtin_amdgcn_s_setprio(0); } while (0)
#define PG8_WAIT_V(n) asm volatile("s_waitcnt vmcnt(" #n ")" ::: "memory")
#define PG8_WAIT_L(n) asm volatile("s_waitcnt lgkmcnt(" #n ")" ::: "memory")
#define PG8_BAR __builtin_amdgcn_s_barrier()
#define PG8_SCHED __builtin_amdgcn_sched_barrier(0)
    Unit cur, nxt; int ui = 0;
    if (!S.next(0, cur)) return;
    f32x4 acc[2][2][4][2];
#pragma unroll
    for (int a = 0; a < 2; ++a)
#pragma unroll
        for (int b = 0; b < 2; ++b)
#pragma unroll
            for (int m = 0; m < 4; ++m)
#pragma unroll
                for (int n = 0; n < 2; ++n) acc[a][b][m][n] = (f32x4){0.f, 0.f, 0.f, 0.f};
    bf16x8 At[4][2], B0[2][2], B1[2][2];
    i32x8 At8[4], B08[2], B18[2];
    i32x6 At6[4], B06[2], B16[2];
    int scl1 = 0x7F7F7F7F; asm volatile("" : "+v"(scl1));
    const char* cA = (const char*)g.A + (size_t)cur.pm * tstep; const char* cB = (const char*)g.Bt + (size_t)cur.pn * tstep;
    S.a_ready(cur);
    if constexpr (MIDK) E.midk_pre(cur, lds, wid);
    if constexpr (SP2) {
        PG8_STAGE(PG8_SB(0, 0), cB, voffB); PG8_STAGE(PG8_SB(0, 1), cB + hstep, voffB); PG8_STAGE(PG8_SA(0, 0), cA, voffA); PG8_STAGE(PG8_SA(0, 1), cA + hstep, voffA);
        if (wr == 1) PG8_BAR;
        PG8_WAIT_V(2); PG8_BAR;
        PG8_STAGE(PG8_SB(1, 0), cB + kstep, voffB); PG8_STAGE(PG8_SA(1, 0), cA + kstep, voffA); PG8_STAGE(PG8_SB(1, 1), cB + hstep + kstep, voffB);
        PG8_WAIT_V(6); PG8_BAR;
    } else {
        PG8_STAGE(PG8_SB(0, 0), cB, voffB); PG8_STAGE(PG8_SA(0, 0), cA, voffA); PG8_STAGE(PG8_SB(0, 1), cB + hstep, voffB); PG8_STAGE(PG8_SA(0, 1), cA + hstep, voffA);
        if (wr == 1) PG8_BAR;
        PG8_WAIT_V(4); PG8_BAR;
        PG8_STAGE(PG8_SB(1, 0), cB + kstep, voffB); PG8_STAGE(PG8_SA(1, 0), cA + kstep, voffA); PG8_STAGE(PG8_SB(1, 1), cB + hstep + kstep, voffB);
        PG8_WAIT_V(6); PG8_BAR;
    }
    for (;;) {
        const bool has_next = S.next(ui + 1, nxt);
        const char* nA = has_next ? (const char*)g.A + (size_t)nxt.pm * tstep : cA; const char* nB = has_next ? (const char*)g.Bt + (size_t)nxt.pn * tstep : cB;
        for (int t = 0; t < nt; t += 2) {
            const bool last = (t == nt - 2);
            const char* a1 = cA + (size_t)(t + 1) * kstep;
            const char* a2 = last ? nA : cA + (size_t)(t + 2) * kstep; const char* b2 = last ? nB : cB + (size_t)(t + 2) * kstep;
            const char* a3 = a2 + kstep; const char* b3 = b2 + kstep;
            if (last && has_next) S.a_ready(nxt);
            if constexpr (MIDK) { if (t == (nt >> 1)) E.midk(acc, lds, wr, fr); }
            if constexpr (Side::ACTIVE) SD.tick(ui * (nt >> 1) + (t >> 1), tid);
            if constexpr (SP2) {
            PG8_LDB(B0, 0, 0); PG8_LDB(B1, 0, 1); PG8_SCHED; PG8_LDA(At, 0, 0); PG8_STAGE(PG8_SA(1, 1), a1 + hstep, voffA);
            PG8_WAIT_V(8); PG8_WAIT_L(0); PG8_BAR; PG8_MMA(0, 0, At, B0); PG8_MMA(0, 1, At, B1); PG8_BAR; PG8_SCHED;
            PG8_LDA(At, 0, 1); PG8_STAGE(PG8_SB(0, 0), b2, voffB); PG8_STAGE(PG8_SB(0, 1), b2 + hstep, voffB); PG8_STAGE(PG8_SA(0, 0), a2, voffA);
            PG8_WAIT_V(8); PG8_WAIT_L(0); PG8_BAR; PG8_MMA(1, 0, At, B0); PG8_MMA(1, 1, At, B1); PG8_BAR; PG8_SCHED;
            PG8_LDB(B0, 1, 0); PG8_LDB(B1, 1, 1); PG8_SCHED; PG8_LDA(At, 1, 0); PG8_STAGE(PG8_SA(0, 1), a2 + hstep, voffA);
            PG8_WAIT_V(8); PG8_WAIT_L(0); PG8_BAR; PG8_MMA(0, 0, At, B0); PG8_MMA(0, 1, At, B1); PG8_BAR; PG8_SCHED;
            PG8_LDA(At, 1, 1); PG8_STAGE(PG8_SB(1, 0), b3, voffB); PG8_STAGE(PG8_SB(1, 1), b3 + hstep, voffB); PG8_STAGE(PG8_SA(1, 0), a3, voffA);
            PG8_WAIT_V(8); PG8_WAIT_L(0); PG8_BAR; PG8_MMA(1, 0, At, B0); PG8_MMA(1, 1, At, B1); PG8_BAR; PG8_SCHED;
            } else {
            PG8_LDB(B0, 0, 0); PG8_SCHED; PG8_LDA(At, 0, 0); PG8_STAGE(PG8_SA(1, 1), a1 + hstep, voffA);
            PG8_WAIT_L(8); PG8_BAR; PG8_WAIT_L(0); PG8_MMA(0, 0, At, B0); PG8_BAR; PG8_SCHED;
            PG8_LDB(B1, 0, 1); PG8_STAGE(PG8_SB(0, 0), b2, voffB);
            PG8_BAR; PG8_WAIT_L(0); PG8_MMA(0, 1, At, B1); PG8_BAR;
            PG8_LDA(At, 0, 1); PG8_STAGE(PG8_SA(0, 0), a2, voffA);
            PG8_BAR; PG8_WAIT_L(0); PG8_MMA(1, 0, At, B0); PG8_BAR; PG8_SCHED;
            PG8_STAGE(PG8_SB(0, 1), b2 + hstep, voffB);
            PG8_WAIT_V(6); PG8_BAR; PG8_MMA(1, 1, At, B1); PG8_BAR;
            PG8_LDB(B0, 1, 0); PG8_SCHED; PG8_LDA(At, 1, 0); PG8_STAGE(PG8_SA(0, 1), a2 + hstep, voffA);
            PG8_WAIT_L(8); PG8_BAR; PG8_WAIT_L(0); PG8_MMA(0, 0, At, B0); PG8_BAR; PG8_SCHED;
            PG8_LDB(B1, 1, 1); PG8_STAGE(PG8_SB(1, 0), b3, voffB);
            PG8_BAR; PG8_WAIT_L(0); PG8_MMA(0, 1, At, B1); PG8_BAR;
            PG8_LDA(At, 1, 1); PG8_STAGE(PG8_SA(1, 0), a3, voffA);
            PG8_BAR; PG8_WAIT_L(0); PG8_MMA(1, 0, At, B0); PG8_BAR; PG8_SCHED;
            PG8_STAGE(PG8_SB(1, 1), b3 + hstep, voffB);
            PG8_WAIT_V(6); PG8_BAR; PG8_MMA(1, 1, At, B1); PG8_BAR;
            }
        }
        if constexpr (ALIGN_EPI) { if (wr == 0) PG8_BAR; }
        if constexpr (FP8) asm volatile("s_nop 15\n\ts_nop 15" ::: "memory");
        if constexpr (!Epi::AFTER_DRAIN) { E(acc, cur, wr, wc, fr, fq); S.done(cur); }
        if (!has_next) break;
#pragma unroll
        for (int a = 0; a < 2; ++a)
#pragma unroll
            for (int b = 0; b < 2; ++b)
#pragma unroll
                for (int m = 0; m < 4; ++m)
#pragma unroll
                    for (int n = 0; n < 2; ++n) acc[a][b][m][n] = (f32x4){0.f, 0.f, 0.f, 0.f};
        cur = nxt; cA = nA; cB = nB; ++ui;
        if constexpr (MIDK) E.midk_pre(cur, lds, wid);
        if constexpr (ALIGN_EPI) { if (wr == 1) PG8_BAR; }
    }
    PG8_WAIT_V(0);
    if constexpr (!ALIGN_EPI) { if (wr == 0) PG8_BAR; }
    PG8_BAR;
    if constexpr (Epi::AFTER_DRAIN) { E.fused(acc, cur, wr, wc, fr, fq, lds, wid, lane); S.done(cur); }
#undef PG8_SA
#undef PG8_SB
#undef PG8_STAGE
#undef PG8_LDA
#undef PG8_LDB
#undef PG8_MMA
#undef PG8_CAT
#undef PG8_CAT6
#undef PG8_WAIT_V
#undef PG8_WAIT_L
#undef PG8_BAR
#undef PG8_SCHED
}
}
namespace pg8 {
constexpr int P6_ROWB = 3072, P6_KT = 96, P6_TILE = 256 * P6_KT, P6_BUF = 2 * P6_TILE, P6_NBUF = 3, P6_NT = P6_ROWB / P6_KT, P6_RING = P6_NBUF * P6_BUF;
template <class Epi, class Sched>
__device__ __forceinline__ void gemm_phase_fp6p(PG8_LAS unsigned char* lds, const unsigned char* Ap, const unsigned char* Bp, const Sched& S, const Epi& E, const int wave_id  ) {
    static_assert(!Epi::AFTER_DRAIN, "in-loop epilogues only");
    unsigned z_ = 0u; asm volatile("" : "+v"(z_)); const int tid_ = (wave_id << 6) | (int)__builtin_amdgcn_mbcnt_hi(~0u, __builtin_amdgcn_mbcnt_lo(~0u, z_));
    const int tid = tid_, wid = __builtin_amdgcn_readfirstlane(tid >> 6), lane = tid & 63, wr = wid >> 2, wc = wid & 3, fr = lane & 15, fq = lane >> 4;
    const unsigned voff = (unsigned)(wid * 3 * 64 + lane) * 16u;
    const size_t tstep = (size_t)P6_NT * P6_TILE;
    const unsigned ldsw = (unsigned)wid * 3072u;
    const int cls_l = fr >> 3, p128 = ((fq == 0) ? 0 : (fq == 1) ? 3 : (fq == 2) ? 2 : 5) * 16, p64 = (((fq < 2) != (cls_l != 0)) ? 1 : 4) * 16 + (fq & 1) * 8;
    const int a128 = (wr * 64 + fr) * P6_KT + p128, a64 = (wr * 64 + fr) * P6_KT + p64, b128 = P6_TILE + (wc * 32 + fr) * P6_KT + p128, b64 = P6_TILE + (wc * 32 + fr) * P6_KT + p64;
#define P6_STAGE(tileoff, gbase) do { _Pragma("unroll") for (int _j = 0; _j < 3; ++_j) \
        __builtin_amdgcn_global_load_lds((const unsigned*)((const char*)(gbase) + voff + _j * 1024), (PG8_LAS unsigned*)(lds + (tileoff) + ldsw + _j * 1024), 16, 0, 0); } while (0)
#define P6_LDA(dst, bo, h) do { _Pragma("unroll") for (int m = 0; m < 4; ++m) dst[m] = pg8_cat6(*(const PG8_LAS i32x4*)(lds + (bo) + a128 + (h) * (128 * P6_KT) + m * (16 * P6_KT)), *(const volatile PG8_LAS i32x2*)(lds + (bo) + a64 + (h) * (128 * P6_KT) + m * (16 * P6_KT))); } while (0)
#define P6_LDB(dst, bo, h) do { _Pragma("unroll") for (int n = 0; n < 2; ++n) dst[n] = pg8_cat6(*(const PG8_LAS i32x4*)(lds + (bo) + b128 + (h) * (128 * P6_KT) + n * (16 * P6_KT)), *(const volatile PG8_LAS i32x2*)(lds + (bo) + b64 + (h) * (128 * P6_KT) + n * (16 * P6_KT))); } while (0)
#define P6_MMA(ai, bj, At, Bt) do { __builtin_amdgcn_s_setprio(1); asm volatile("s_nop 4" ::: "memory"); _Pragma("unroll") for (int m = 0; m < 4; ++m) _Pragma("unroll") for (int n = 0; n < 2; ++n) \
        asm volatile("v_mfma_scale_f32_16x16x128_f8f6f4 %0, %1, %2, %0, %3, %3 op_sel_hi:[0,0,0] cbsz:2 blgp:2" : "+v"(acc[ai][bj][m][n]) : "v"(Bt[n]), "v"(At[m]), "v"(scl1)); \
        __builtin_amdgcn_s_setprio(0); } while (0)
#define P6_WAIT_V(n) asm volatile("s_waitcnt vmcnt(" #n ")" ::: "memory")
#define P6_WAIT_L(n) asm volatile("s_waitcnt lgkmcnt(" #n ")" ::: "memory")
#define P6_BAR __builtin_amdgcn_s_barrier()
#define P6_SCHED __builtin_amdgcn_sched_barrier(0)
    Unit cur, nxt; int ui = 0;
    if (!S.next(0, cur)) return;
    f32x4 acc[2][2][4][2];
#pragma unroll
    for (int a = 0; a < 2; ++a)
#pragma unroll
        for (int b = 0; b < 2; ++b)
#pragma unroll
            for (int m = 0; m < 4; ++m)
#pragma unroll
                for (int n = 0; n < 2; ++n) acc[a][b][m][n] = (f32x4){0.f, 0.f, 0.f, 0.f};
    i32x6 At[4], B0[2], B1[2];
    int scl1 = 0x7F7F7F7F; asm volatile("" : "+v"(scl1));
    const char* cA = (const char*)Ap + (size_t)cur.pm * tstep; const char* cB = (const char*)Bp + (size_t)cur.pn * tstep;
    S.a_ready(cur);
    P6_STAGE(P6_TILE, cB); P6_STAGE(0, cA); P6_STAGE(P6_BUF + P6_TILE, cB + P6_TILE); P6_STAGE(P6_BUF, cA + P6_TILE);
    if (wr == 1) P6_BAR;
    P6_WAIT_V(6); P6_BAR;
    P6_BAR;
    int boc = 0, bos = 2 * P6_BUF;
    for (;;) {
        const bool has_next = S.next(ui + 1, nxt);
        const char* nA = has_next ? (const char*)Ap + (size_t)nxt.pm * tstep : cA; const char* nB = has_next ? (const char*)Bp + (size_t)nxt.pn * tstep : cB;
#pragma unroll 1
        for (int t = 0; t < P6_NT; ++t) {
            const bool wrap = (t + 2 >= P6_NT);
            const char* a2 = (wrap ? nA : cA) + (size_t)(wrap ? t + 2 - P6_NT : t + 2) * P6_TILE; const char* b2 = (wrap ? nB : cB) + (size_t)(wrap ? t + 2 - P6_NT : t + 2) * P6_TILE;
            if (t == P6_NT - 2 && has_next) S.a_ready(nxt);
            P6_LDB(B0, boc, 0); P6_LDB(B1, boc, 1); P6_SCHED; P6_LDA(At, boc, 0); P6_STAGE(bos + P6_TILE, b2);
            P6_WAIT_L(0); P6_BAR; P6_MMA(0, 0, At, B0); P6_MMA(0, 1, At, B1); P6_BAR; P6_SCHED;
            P6_LDA(At, boc, 1); P6_STAGE(bos, a2);
            P6_WAIT_V(6); P6_WAIT_L(0); P6_BAR; P6_MMA(1, 0, At, B0); P6_MMA(1, 1, At, B1); P6_BAR; P6_SCHED;
            boc = (boc == 2 * P6_BUF) ? 0 : boc + P6_BUF; bos = (bos == 2 * P6_BUF) ? 0 : bos + P6_BUF;
        }
        if (wr == 0) P6_BAR;
        asm volatile("s_nop 15\n\ts_nop 15" ::: "memory");
        E(acc, cur, wr, wc, fr, fq); S.done(cur);
        if (!has_next) break;
#pragma unroll
        for (int a = 0; a < 2; ++a)
#pragma unroll
            for (int b = 0; b < 2; ++b)
#pragma unroll
                for (int m = 0; m < 4; ++m)
#pragma unroll
                    for (int n = 0; n < 2; ++n) acc[a][b][m][n] = (f32x4){0.f, 0.f, 0.f, 0.f};
        cur = nxt; cA = nA; cB = nB; ++ui;
        if (wr == 1) P6_BAR;
    }
    P6_WAIT_V(0);
    P6_BAR;
#undef P6_STAGE
#undef P6_LDA
#undef P6_LDB
#undef P6_MMA
#undef P6_WAIT_V
#undef P6_WAIT_L
#undef P6_BAR
#undef P6_SCHED
}
}
namespace attn128 {
using bf16 = __hip_bfloat16;
constexpr int   D = 128, NW = 8, QBLK = 32, KVBLK = 64;
constexpr float SCALE = 0.088388347648318440f;
constexpr float THR = 8.f;
constexpr int SDEPTH = 2;
constexpr int LDQ = 9216, LDK = 9216, LDO = 4096;
constexpr int NBUF = 3;
constexpr size_t SHM_V = KVBLK * D * 2, SHM_K = KVBLK * D * 2, SHM_ATTN = NBUF * SHM_V + NBUF * SHM_K + NW * 64 * 4;
using bf16x8 = __attribute__((ext_vector_type(8))) short;
using s16x4  = __attribute__((ext_vector_type(4))) short;
using f32x16 = __attribute__((ext_vector_type(16))) float;
using f32x8  = __attribute__((ext_vector_type(8))) float;
using u32x4  = __attribute__((ext_vector_type(4))) unsigned;
#define KSWZ(row, colB) ((row) * 256 + ((colB) ^ (((row) & 7) << 4)))
#define SBAR() __builtin_amdgcn_sched_barrier(0)
__device__ __forceinline__ int crow(int r, int hi) { return (r & 3) + 8 * (r >> 2) + 4 * hi; }
__device__ __forceinline__ unsigned cvtpk(float lo, float hi) {
  unsigned r; asm volatile("v_cvt_pk_bf16_f32 %0, %1, %2" : "=v"(r) : "v"(lo), "v"(hi)); return r;
}
template <typename TIn> struct Stage;
template <> struct Stage<bf16>  { using T = bf16x8;
  __device__ static __forceinline__ T ld8(const bf16* p) { return *reinterpret_cast<const bf16x8*>(p); }
  __device__ static __forceinline__ bf16x8 tobf(T x) { return x; } };
template <> struct Stage<float> { using T = f32x8;
  __device__ static __forceinline__ T ld8(const float* p) { return *reinterpret_cast<const f32x8*>(p); }
  __device__ static __forceinline__ bf16x8 tobf(T x) {
    u32x4 w = {cvtpk(x[0], x[1]), cvtpk(x[2], x[3]), cvtpk(x[4], x[5]), cvtpk(x[6], x[7])}; return *reinterpret_cast<bf16x8*>(&w); } };

template <bool NOSHIFT, bool PV8 = false> __device__ __forceinline__ void partialSM(f32x16& p0, f32x16& p1, float& m_reg, float& mn, float& alpha) {
  constexpr float C = SCALE * 1.4426950408889634f;
  if constexpr (NOSHIFT) { mn = 0.f; alpha = 1.f; for (int r = 0; r < 16; ++r) p0[r] = __builtin_amdgcn_exp2f(p0[r]); return; }
  float pmax = p0[0]; for (int r = 1; r < 16; ++r) pmax = fmaxf(pmax, p0[r]); for (int r = 0; r < 16; ++r) pmax = fmaxf(pmax, p1[r]);
  { auto rr = __builtin_amdgcn_permlane32_swap(__float_as_uint(pmax), __float_as_uint(pmax), false, false);
    pmax = fmaxf(__uint_as_float(rr[0]), __uint_as_float(rr[1])); }
  constexpr float TH = PV8 ? 2.f : THR;
  if (__builtin_expect(__all(pmax - m_reg <= TH / SCALE), 1)) { mn = m_reg; alpha = 1.f; }
  else { mn = fmaxf(m_reg, pmax); alpha = __builtin_amdgcn_exp2f((m_reg - mn) * C); m_reg = mn; }
  float mnC = -mn * C + (PV8 ? 5.f : 0.f);
  for (int r = 0; r < 16; ++r) p0[r] = fmaf(p0[r], C, mnC); for (int r = 0; r < 16; ++r) p1[r] = fmaf(p1[r], C, mnC);
  for (int r = 0; r < 16; ++r) p0[r] = __builtin_amdgcn_exp2f(p0[r]);
}
__device__ __forceinline__ void finishSM(f32x16& p0, f32x16& p1, float alpha, float& l_reg, bf16x8& pa0, bf16x8& pa1, bf16x8& pa2, bf16x8& pa3) {
  for (int r = 0; r < 16; ++r) p1[r] = __builtin_amdgcn_exp2f(p1[r]);
  float ps = 0; for (int r = 0; r < 16; ++r) ps += p0[r]; for (int r = 0; r < 16; ++r) ps += p1[r];
  { auto rr = __builtin_amdgcn_permlane32_swap(__float_as_uint(ps), __float_as_uint(ps), false, false);
    ps = __uint_as_float(rr[0]) + __uint_as_float(rr[1]); }
  l_reg = l_reg * alpha + ps;
#define PK4(P, BASE, OUT) do { unsigned a0 = cvtpk(P[BASE + 0], P[BASE + 1]), a1 = cvtpk(P[BASE + 2], P[BASE + 3]);   \
    unsigned b0 = cvtpk(P[BASE + 4], P[BASE + 5]), b1 = cvtpk(P[BASE + 6], P[BASE + 7]);                              \
    auto r0 = __builtin_amdgcn_permlane32_swap(a0, b0, false, false); auto r1 = __builtin_amdgcn_permlane32_swap(a1, b1, false, false); \
    u32x4 w = {r0[0], r1[0], r0[1], r1[1]}; OUT = *reinterpret_cast<bf16x8*>(&w); } while (0)
  PK4(p0, 0, pa0); PK4(p0, 8, pa1); PK4(p1, 0, pa2); PK4(p1, 8, pa3);
#undef PK4
}
__device__ __forceinline__ void qkt(f32x16& p0, f32x16& p1, const bf16* Ks, const bf16x8* qr, int r32, int hi) {
  p0 = f32x16{}; p1 = f32x16{};
  for (int d0 = 0; d0 < 8; ++d0) { int cb = (d0 * 16 + hi * 8) * 2;
    bf16x8 b0 = *reinterpret_cast<const bf16x8*>((const char*)Ks + KSWZ(r32, cb));
    bf16x8 b1 = *reinterpret_cast<const bf16x8*>((const char*)Ks + KSWZ(32 + r32, cb));
    p0 = __builtin_amdgcn_mfma_f32_32x32x16_bf16(b0, qr[d0], p0, 0, 0, 0);
    p1 = __builtin_amdgcn_mfma_f32_32x32x16_bf16(b1, qr[d0], p1, 0, 0, 0); }
}
#define K8SWZ(row, c) ((row) * 128 + ((((c) ^ (((row) >> 1) & 7))) << 4))
using i32x4v = __attribute__((ext_vector_type(4))) int;
using i32x16v = __attribute__((ext_vector_type(16))) int;
__device__ __forceinline__ void qkt_i8(f32x16& p0, f32x16& p1, const char* Ks, const i32x4v* qi, int r32, int hi, float dq) {
  i32x16v a0 = {}, a1 = {};
#pragma unroll
  for (int s4 = 0; s4 < 4; ++s4) {
    const i32x4v b0 = *reinterpret_cast<const i32x4v*>(Ks + K8SWZ(r32, 2 * s4 + hi));
    const i32x4v b1 = *reinterpret_cast<const i32x4v*>(Ks + K8SWZ(32 + r32, 2 * s4 + hi));
    a0 = __builtin_amdgcn_mfma_i32_32x32x32_i8(b0, qi[s4], a0, 0, 0, 0);
    a1 = __builtin_amdgcn_mfma_i32_32x32x32_i8(b1, qi[s4], a1, 0, 0, 0); }
#pragma unroll
  for (int r = 0; r < 16; ++r) { p0[r] = (float)a0[r] * dq; p1[r] = (float)a1[r] * dq; }
}
__device__ __forceinline__ void qkt_i8_raw(f32x16& p0, f32x16& p1, const char* Ks, const i32x4v* qi, int r32, int hi) {
  i32x16v a0 = {}, a1 = {};
#pragma unroll
  for (int s4 = 0; s4 < 4; ++s4) {
    const i32x4v b0 = *reinterpret_cast<const i32x4v*>(Ks + K8SWZ(r32, 2 * s4 + hi));
    const i32x4v b1 = *reinterpret_cast<const i32x4v*>(Ks + K8SWZ(32 + r32, 2 * s4 + hi));
    a0 = __builtin_amdgcn_mfma_i32_32x32x32_i8(b0, qi[s4], a0, 0, 0, 0);
    a1 = __builtin_amdgcn_mfma_i32_32x32x32_i8(b1, qi[s4], a1, 0, 0, 0); }
  p0 = __builtin_bit_cast(f32x16, a0); p1 = __builtin_bit_cast(f32x16, a1);
}
__device__ __forceinline__ void partialSM8(f32x16& p0, f32x16& p1, float dq, float& m_reg, float& mn, float& alpha) {
  const i32x16v a0 = __builtin_bit_cast(i32x16v, p0), a1 = __builtin_bit_cast(i32x16v, p1);
  int im = a0[0]; for (int r = 1; r < 16; ++r) im = max(im, a0[r]); for (int r = 0; r < 16; ++r) im = max(im, a1[r]);
  float pmax = (float)im * dq;
  { auto rr = __builtin_amdgcn_permlane32_swap(__float_as_uint(pmax), __float_as_uint(pmax), false, false);
    pmax = fmaxf(__uint_as_float(rr[0]), __uint_as_float(rr[1])); }
  if (__builtin_expect(__all(pmax - m_reg <= 1.4426950408889634f), 1)) { mn = m_reg; alpha = 1.f; }
  else { mn = fmaxf(m_reg, pmax); alpha = __builtin_amdgcn_exp2f(m_reg - mn); m_reg = mn; }
  const float mnC = 7.f - mn;
  using f32x2 = __attribute__((ext_vector_type(2))) float;
  const f32x2 dq2 = {dq, dq}, mn2 = {mnC, mnC};
#pragma unroll
  for (int r = 0; r < 16; r += 2) { const f32x2 x = {(float)a0[r], (float)a0[r + 1]}, y = {(float)a1[r], (float)a1[r + 1]};
    const f32x2 u = __builtin_elementwise_fma(x, dq2, mn2), w = __builtin_elementwise_fma(y, dq2, mn2); p0[r] = u[0]; p0[r + 1] = u[1]; p1[r] = w[0]; p1[r + 1] = w[1]; }
  for (int r = 0; r < 16; ++r) p0[r] = __builtin_amdgcn_exp2f(p0[r]);
}
using i32x8q = __attribute__((ext_vector_type(8))) int;
__device__ __forceinline__ void qkt_f6(f32x16& p0, f32x16& p1, const char* Ks, const i32x8q* qf, int r32, int hi, int scl) {
  p0 = f32x16{}; p1 = f32x16{};
#pragma unroll
  for (int s = 0; s < 2; ++s) {
    using i32x2q = __attribute__((ext_vector_type(2))) int;
    const i32x4v a0 = *reinterpret_cast<const i32x4v*>(Ks + K8SWZ(r32, 4 * s + 2 * hi)), b0 = *reinterpret_cast<const i32x4v*>(Ks + K8SWZ(32 + r32, 4 * s + 2 * hi));
    const i32x2q a1 = *reinterpret_cast<const i32x2q*>(Ks + K8SWZ(r32, 4 * s + 2 * hi + 1)), b1 = *reinterpret_cast<const i32x2q*>(Ks + K8SWZ(32 + r32, 4 * s + 2 * hi + 1));
    const i32x8q ka = __builtin_shufflevector(a0, __builtin_shufflevector(a1, a1, 0, 1, -1, -1), 0, 1, 2, 3, 4, 5, 6, 7), kb = __builtin_shufflevector(b0, __builtin_shufflevector(b1, b1, 0, 1, -1, -1), 0, 1, 2, 3, 4, 5, 6, 7);
    p0 = __builtin_amdgcn_mfma_scale_f32_32x32x64_f8f6f4(ka, qf[s], p0, 2, 2, 0, scl, 0, scl);
    p1 = __builtin_amdgcn_mfma_scale_f32_32x32x64_f8f6f4(kb, qf[s], p1, 2, 2, 0, scl, 0, scl); }
}
__device__ __forceinline__ void partialSM8f(f32x16& p0, f32x16& p1, float dq, float& m_reg, float& mn, float& alpha) {
  float pmax = p0[0]; for (int r = 1; r < 16; ++r) pmax = fmaxf(pmax, p0[r]); for (int r = 0; r < 16; ++r) pmax = fmaxf(pmax, p1[r]);
  pmax *= dq;
  { auto rr = __builtin_amdgcn_permlane32_swap(__float_as_uint(pmax), __float_as_uint(pmax), false, false);
    pmax = fmaxf(__uint_as_float(rr[0]), __uint_as_float(rr[1])); }
  if (__builtin_expect(__all(pmax - m_reg <= 1.4426950408889634f), 1)) { mn = m_reg; alpha = 1.f; }
  else { mn = fmaxf(m_reg, pmax); alpha = __builtin_amdgcn_exp2f(m_reg - mn); m_reg = mn; }
  const float mnC = 7.f - mn;
  for (int r = 0; r < 16; ++r) p0[r] = fmaf(p0[r], dq, mnC); for (int r = 0; r < 16; ++r) p1[r] = fmaf(p1[r], dq, mnC);
  for (int r = 0; r < 16; ++r) p0[r] = __builtin_amdgcn_exp2f(p0[r]);
}
__device__ __forceinline__ unsigned pk4_i8_rn(float a, float b, float c, float d) {
  const int ia = (int)__builtin_rintf(a), ib = (int)__builtin_rintf(b), ic = (int)__builtin_rintf(c), id = (int)__builtin_rintf(d);
  return (unsigned)(ia & 0xff) | ((unsigned)(ib & 0xff) << 8) | ((unsigned)(ic & 0xff) << 16) | ((unsigned)id << 24);
}
__device__ __forceinline__ int v_st(int k, int c) { const int kk = (k & ~0xC) | ((k & 4) << 1) | ((k & 8) >> 1); return ((kk >> 3) * 4 + (c >> 5)) * 512 + ((kk & 7) * 32 + (c & 31)) * 2; }
__device__ __forceinline__ int v_rd_base(int lane) { return ((lane & 3) << 3) | (((lane >> 2) & 3) << 6) | (((lane >> 4) & 1) << 5) | (((lane >> 5) & 1) << 8); }
constexpr int v_rd_off(int d0, int ks, int half) { return d0 * 512 + ks * 4096 + half * 2048; }
template <int OFF> __device__ __forceinline__ s16x4 tr_read(int vb) {
  s16x4 r; asm volatile("ds_read_b64_tr_b16 %0, %1 offset:%2" : "=&v"(r) : "v"(vb), "i"(OFF) : "memory"); return r;
}
template <int D0> __device__ __forceinline__ void pv_one(f32x16& od, int vb, bf16x8 pa0, bf16x8 pa1, bf16x8 pa2, bf16x8 pa3) {
  const s16x4 l0 = tr_read<v_rd_off(D0, 0, 0)>(vb), h0 = tr_read<v_rd_off(D0, 0, 1)>(vb), l1 = tr_read<v_rd_off(D0, 1, 0)>(vb), h1 = tr_read<v_rd_off(D0, 1, 1)>(vb);
  const s16x4 l2 = tr_read<v_rd_off(D0, 2, 0)>(vb), h2 = tr_read<v_rd_off(D0, 2, 1)>(vb), l3 = tr_read<v_rd_off(D0, 3, 0)>(vb), h3 = tr_read<v_rd_off(D0, 3, 1)>(vb);
  asm volatile("s_waitcnt lgkmcnt(0)" ::: "memory"); SBAR();
#define PK(L, H) (bf16x8){L[0], L[1], L[2], L[3], H[0], H[1], H[2], H[3]}
  od = __builtin_amdgcn_mfma_f32_32x32x16_bf16(pa0, PK(l0, h0), od, 0, 0, 0);
  od = __builtin_amdgcn_mfma_f32_32x32x16_bf16(pa1, PK(l1, h1), od, 0, 0, 0);
  od = __builtin_amdgcn_mfma_f32_32x32x16_bf16(pa2, PK(l2, h2), od, 0, 0, 0);
  od = __builtin_amdgcn_mfma_f32_32x32x16_bf16(pa3, PK(l3, h3), od, 0, 0, 0);
#undef PK
}
__device__ __forceinline__ void pv_d0(f32x16* o, int vb, bf16x8 pa0, bf16x8 pa1, bf16x8 pa2, bf16x8 pa3) {
  pv_one<0>(o[0], vb, pa0, pa1, pa2, pa3); pv_one<1>(o[1], vb, pa0, pa1, pa2, pa3); pv_one<2>(o[2], vb, pa0, pa1, pa2, pa3); pv_one<3>(o[3], vb, pa0, pa1, pa2, pa3);
}

using i32x8v = __attribute__((ext_vector_type(8))) int;
__device__ __forceinline__ int pk4_f8(float a, float b, float c, float d, int w) { w = __builtin_amdgcn_cvt_pk_fp8_f32(a, b, w, false); w = __builtin_amdgcn_cvt_pk_fp8_f32(c, d, w, true); return w; }
__device__ __forceinline__ void finishSM8(f32x16& p0, f32x16& p1, float alpha, float& l_reg, i32x8v& pa) {
  for (int r = 0; r < 16; ++r) p1[r] = __builtin_amdgcn_exp2f(p1[r]);
  using f32x2 = __attribute__((ext_vector_type(2))) float;
  f32x2 s2 = {p0[0], p0[1]}, t2 = {p1[0], p1[1]};
#pragma unroll
  for (int r = 2; r < 16; r += 2) { s2 += (f32x2){p0[r], p0[r + 1]}; t2 += (f32x2){p1[r], p1[r + 1]}; }
  s2 += t2; float ps = s2[0] + s2[1];
  { auto rr = __builtin_amdgcn_permlane32_swap(__float_as_uint(ps), __float_as_uint(ps), false, false);
    ps = __uint_as_float(rr[0]) + __uint_as_float(rr[1]); }
  l_reg = l_reg * alpha + ps;
#pragma unroll
  for (int j = 0; j < 4; ++j) { pa[j] = pk4_f8(p0[4 * j], p0[4 * j + 1], p0[4 * j + 2], p0[4 * j + 3], pa[j]); pa[4 + j] = pk4_f8(p1[4 * j], p1[4 * j + 1], p1[4 * j + 2], p1[4 * j + 3], pa[4 + j]); }
}
__device__ __forceinline__ void pv8_d0(f32x16* o, const char* Vs, int va, int vb, i32x8v pa, int scl) {
  i32x4v x[4][2];
#pragma unroll
  for (int d0 = 0; d0 < 4; ++d0) { x[d0][0] = *reinterpret_cast<const i32x4v*>(Vs + va + d0 * 2048); x[d0][1] = *reinterpret_cast<const i32x4v*>(Vs + vb + d0 * 2048); }
#pragma unroll
  for (int d0 = 0; d0 < 4; ++d0) { const i32x8v v = {x[d0][0][0], x[d0][0][1], x[d0][0][2], x[d0][0][3], x[d0][1][0], x[d0][1][1], x[d0][1][2], x[d0][1][3]};
    o[d0] = __builtin_amdgcn_mfma_scale_f32_32x32x64_f8f6f4(pa, v, o[d0], 0, 0, 0, scl, 0, scl); }
}

template <typename TQ, bool NOSHIFT, bool QRAW, bool KI8 = false, bool PV8 = false>
__device__ __forceinline__ void attn_dense_body(const TQ* __restrict__ Qb, const bf16* __restrict__ Kh, const bf16* __restrict__ Vh,
                                                bf16* __restrict__ Ob, int seq, char* lds, const int wave_id, const float* __restrict__ qg, const int spos0, const float k_inv_scale = 1.f, const float v_inv_scale = 1.f) {
  static_assert(!PV8 || (KI8 && !NOSHIFT), "fp8 P.V: int8 keys, shifted softmax");
  using St = Stage<bf16>; using SQ = Stage<TQ>;
  unsigned z_ = 0u; asm volatile("" : "+v"(z_)); const int tid_ = (wave_id << 6) | (int)__builtin_amdgcn_mbcnt_hi(~0u, __builtin_amdgcn_mbcnt_lo(~0u, z_));
  const int tid = tid_, wid = tid >> 6, lane = tid & 63, r32 = lane & 31, hi = lane >> 5;
  bf16* V_lds = (bf16*)lds; bf16* K_lds = (bf16*)(lds + NBUF * SHM_V);
  float* ws = (float*)(lds + NBUF * SHM_V + NBUF * SHM_K) + wid * 64; float* li_l = ws; float* al_l = ws + 32;
  float m_reg = -1e30f, l_reg = 0; f32x16 o[4] = {}; bf16x8 qr[8]; i32x4v qi[4]; i32x8q qf[2]; float dq = 1.f;
  const TQ* Qw = Qb + (long)(wid * QBLK + r32) * LDQ + hi * 8;
  if constexpr (QRAW) {
    float q[8][8]; float ss = 0.f;
#pragma unroll
    for (int d0 = 0; d0 < 8; ++d0) { const bf16x8 raw = SQ::tobf(SQ::ld8(Qw + d0 * 16)); const u32x4 w = *reinterpret_cast<const u32x4*>(&raw);
#pragma unroll
      for (int e = 0; e < 4; ++e) { q[d0][2 * e] = __uint_as_float(w[e] << 16); q[d0][2 * e + 1] = __uint_as_float(w[e] & 0xffff0000u); }
#pragma unroll
      for (int e = 0; e < 8; ++e) ss += q[d0][e] * q[d0][e]; }
    { auto rr = __builtin_amdgcn_permlane32_swap(__float_as_uint(ss), __float_as_uint(ss), false, false); ss = __uint_as_float(rr[0]) + __uint_as_float(rr[1]); }
    const float rstd = 1.0f / sqrtf(ss * (1.0f / 128.0f) + 1e-6f);
#pragma unroll
    for (int d0 = 0; d0 < 8; ++d0) { const float* gp = qg + d0 * 16 + hi * 8; const float4 g0 = *reinterpret_cast<const float4*>(gp), g1 = *reinterpret_cast<const float4*>(gp + 4);
      q[d0][0] *= rstd * g0.x; q[d0][1] *= rstd * g0.y; q[d0][2] *= rstd * g0.z; q[d0][3] *= rstd * g0.w; q[d0][4] *= rstd * g1.x; q[d0][5] *= rstd * g1.y; q[d0][6] *= rstd * g1.z; q[d0][7] *= rstd * g1.w; }
    const int spos = spos0 + wid * QBLK + r32;
#pragma unroll
    for (int hf = 0; hf < 2; ++hf) { const float pos = (float)(hf ? (spos & 63) : (spos >> 6));
#pragma unroll
      for (int aa = 0; aa < 2; ++aa)
#pragma unroll
        for (int e = 0; e < 8; ++e) { const float inv = exp2f(-(float)(16 * aa + 8 * hi + e) * (13.287712379549449f / 32.0f));
          float rev = pos * inv * 0.15915494309189535f; rev = rev - floorf(rev);
          const float cs = __builtin_amdgcn_cosf(rev), sn = __builtin_amdgcn_sinf(rev);
          const float x1 = q[4 * hf + aa][e], x2 = q[4 * hf + aa + 2][e];
          q[4 * hf + aa][e] = x1 * cs - x2 * sn; q[4 * hf + aa + 2][e] = x1 * sn + x2 * cs; } }
    constexpr float CQ = (NOSHIFT || PV8) ? SCALE * 1.4426950408889634f : 1.0f;
    if constexpr (KI8) {
      float mxq = 0.f;
#pragma unroll
      for (int d0 = 0; d0 < 8; ++d0)
#pragma unroll
        for (int e = 0; e < 8; ++e) mxq = fmaxf(mxq, fabsf(q[d0][e]));
      { auto rr = __builtin_amdgcn_permlane32_swap(__float_as_uint(mxq), __float_as_uint(mxq), false, false); mxq = fmaxf(__uint_as_float(rr[0]), __uint_as_float(rr[1])); }
      const float sq = mxq > 0.f ? 7.5f / mxq : 0.f;
      dq = mxq * (1.f / 7.5f) * k_inv_scale * CQ;
#pragma unroll
      for (int s = 0; s < 2; ++s) { pg8::f32x16v ya, yb;
#pragma unroll
        for (int e = 0; e < 8; ++e) {
          auto r0 = __builtin_amdgcn_permlane32_swap(__float_as_uint(q[4 * s][e]), __float_as_uint(q[4 * s + 2][e]), false, false);
          auto r1 = __builtin_amdgcn_permlane32_swap(__float_as_uint(q[4 * s + 1][e]), __float_as_uint(q[4 * s + 3][e]), false, false);
          ya[e] = __uint_as_float(r0[0]) * sq; ya[8 + e] = __uint_as_float(r0[1]) * sq; yb[e] = __uint_as_float(r1[0]) * sq; yb[8 + e] = __uint_as_float(r1[1]) * sq; }
        const pg8::i32x6 w6 = __builtin_amdgcn_cvt_scalef32_2xpk16_fp6_f32(ya, yb, 1.0f);
        qf[s] = (i32x8q){w6[0], w6[1], w6[2], w6[3], w6[4], w6[5], 0, 0}; }
    } else {
#pragma unroll
    for (int d0 = 0; d0 < 8; ++d0) { u32x4 w;
#pragma unroll
      for (int e = 0; e < 4; ++e) w[e] = cvtpk(q[d0][2 * e] * CQ, q[d0][2 * e + 1] * CQ);
      qr[d0] = *reinterpret_cast<bf16x8*>(&w); }
    }
  } else {
#pragma unroll
  for (int d0 = 0; d0 < 8; ++d0) { qr[d0] = SQ::tobf(SQ::ld8(Qw + d0 * 16));
    if constexpr (NOSHIFT) { constexpr float C = SCALE * 1.4426950408889634f; u32x4 w = *reinterpret_cast<u32x4*>(&qr[d0]);
      for (int e = 0; e < 4; ++e) w[e] = cvtpk(__uint_as_float(w[e] << 16) * C, __uint_as_float(w[e] & 0xffff0000u) * C);
      qr[d0] = *reinterpret_cast<bf16x8*>(&w); } }
  }
  const unsigned lds0 = (unsigned)(uintptr_t)lds;
  long koff[2], voff[2];
#pragma unroll
  for (int i = 0; i < 2; ++i) { const int ci = 2 * wid + i;
    if constexpr (KI8) { const int pch = 64 * wid + lane, r = pch >> 3, c = (pch & 7) ^ ((r >> 1) & 7); koff[i] = (long)r * 128 + c * 16; }
    else { const int r = 4 * ci + (lane >> 4), q = lane & 15, c = q ^ (r & 7); koff[i] = ((long)r * LDK + c * 8) * 2; }
    if constexpr (PV8) voff[i] = 1024 * wid + 16 * lane;
    else { const int p = 64 * ci + lane, sb = p >> 5, jj = p & 31, kk = (sb >> 2) * 8 + (jj >> 2), k = (kk & ~0xC) | ((kk & 4) << 1) | ((kk & 8) >> 1), c = (sb & 3) * 32 + (jj & 3) * 8;
      voff[i] = ((long)k * LDK + c) * 2; } }
  const int v8a = r32 * 64 + (((2 * hi) ^ ((r32 >> 2) & 3)) << 4), v8b = r32 * 64 + (((2 * hi + 1) ^ ((r32 >> 2) & 3)) << 4);
  int scl1 = 0x7F7F7F7F; asm volatile("" : "+v"(scl1));
  const int vb0 = (int)(uintptr_t)V_lds + v_rd_base(lane);
#define GLDS16(gsrc, ldsdst) do { unsigned keep_; asm volatile("s_mov_b32 %0, m0\n\ts_mov_b32 m0, %2\n\ts_nop 0\n\tglobal_load_lds_dwordx4 %1, off\n\ts_mov_b32 m0, %0" : "=&s"(keep_) : "v"(gsrc), "s"(ldsdst) : "memory"); } while (0)
#define DMA_TILE(t, bo) do { const char* kt_ = KI8 ? (const char*)Kh + (long)(t) * KVBLK * 128 : (const char*)Kh + (long)(t) * KVBLK * LDK * 2; const char* vt_ = PV8 ? (const char*)Vh + (long)(t) * 8192 : (const char*)Vh + (long)(t) * KVBLK * LDK * 2; \
    const unsigned kd_ = (unsigned)__builtin_amdgcn_readfirstlane((int)(lds0 + NBUF * SHM_V + (bo) + wid * (KI8 ? 1024 : 2048))), vd_ = (unsigned)__builtin_amdgcn_readfirstlane((int)(lds0 + (bo) + wid * (PV8 ? 1024 : 2048))); \
    GLDS16(kt_ + koff[0], kd_); if constexpr (!KI8) GLDS16(kt_ + koff[1], kd_ + 1024u); GLDS16(vt_ + voff[0], vd_); if constexpr (!PV8) GLDS16(vt_ + voff[1], vd_ + 1024u); } while (0)
#define PSM(P0, P1, MN, AL) do { if constexpr (PV8) partialSM8f(P0, P1, dq, m_reg, MN, AL); else partialSM<NOSHIFT, PV8>(P0, P1, m_reg, MN, AL); } while (0)
#define QKT(P0, P1, KS) do { if constexpr (PV8) qkt_f6(P0, P1, KS, qf, r32, hi, scl1); else if constexpr (KI8) qkt_i8(P0, P1, KS, qi, r32, hi, dq); else qkt(P0, P1, (const bf16*)(KS), qr, r32, hi); } while (0)
#define WAIT_BAR() asm volatile("s_waitcnt vmcnt(0) lgkmcnt(0)\n\ts_barrier" ::: "memory")
#define RESC(a) do { if (__any((a) < 1.f)) { if (hi == 0) al_l[r32] = (a); asm volatile("s_waitcnt lgkmcnt(0)" ::: "memory"); \
    for (int d = 0; d < 4; ++d) for (int r = 0; r < 16; ++r) o[d][r] *= al_l[crow(r, hi)]; } } while (0)
  f32x16 pA0, pA1, pB0, pB1; float mnA, mnB, alA, alB; bf16x8 pa0, pa1, pa2, pa3; i32x8v pa8 = {}; const int NT = seq / KVBLK;
#define FIN(P0, P1, AL) do { if constexpr (PV8) finishSM8(P0, P1, AL, l_reg, pa8); else finishSM(P0, P1, AL, l_reg, pa0, pa1, pa2, pa3); } while (0)
#define PVD(BO) do { if constexpr (PV8) pv8_d0(o, (const char*)V_lds + (BO), v8a, v8b, pa8, scl1); else pv_d0(o, vb0 + (BO), pa0, pa1, pa2, pa3); } while (0)
  constexpr int SE = 0, SO = SDEPTH - 1;
  DMA_TILE(0, 0); DMA_TILE(1, (int)SHM_V); WAIT_BAR();
  QKT(pA0, pA1, (const char*)K_lds); PSM(pA0, pA1, mnA, alA);
  int bo_prev = 0, bo_cur = (int)SHM_V, bo_next = 2 * (int)SHM_V;
#define ROT() do { bo_prev = bo_cur; bo_cur = bo_next; bo_next = (bo_next == (NBUF - 1) * (int)SHM_V) ? 0 : bo_next + (int)SHM_V; } while (0)
  for (int j = 1; j + 1 < NT; j += 2) {
    DMA_TILE(j + 1, bo_next);
    SBAR(); QKT(pB0, pB1, (const char*)K_lds + bo_cur);
    FIN(pA0, pA1, alA); SBAR();
    PVD(bo_prev); PSM(pB0, pB1, mnB, alB);
    RESC(alB); WAIT_BAR(); ROT();
    if (j + 2 < NT) DMA_TILE(j + 2, bo_next);
    SBAR(); QKT(pA0, pA1, (const char*)K_lds + bo_cur);
    FIN(pB0, pB1, alB); SBAR();
    PVD(bo_prev); PSM(pA0, pA1, mnA, alA);
    RESC(alA); WAIT_BAR(); ROT();
  }
  SBAR(); QKT(pB0, pB1, (const char*)K_lds + bo_cur);
  FIN(pA0, pA1, alA); SBAR();
  PVD(bo_prev); PSM(pB0, pB1, mnB, alB);
  RESC(alB);
  FIN(pB0, pB1, alB); SBAR();
  PVD(bo_cur);
#undef ROT
  if (hi == 0) li_l[r32] = l_reg; asm volatile("s_waitcnt lgkmcnt(0)" ::: "memory");
  float rli[16];
  unsigned ze_ = 0u; asm volatile("" : "+v"(ze_)); const int lane_e = (int)__builtin_amdgcn_mbcnt_hi(~0u, __builtin_amdgcn_mbcnt_lo(~0u, ze_)), hi_e = lane_e >> 5, r32_e = lane_e & 31;
#pragma unroll
  for (int r = 0; r < 16; ++r) rli[r] = __builtin_amdgcn_rcpf(li_l[crow(r, hi_e)]) * v_inv_scale;
  bf16* Ow = Ob + (long)(wid * QBLK) * LDO;
#pragma unroll
  for (int r = 0; r < 16; ++r) { int orow = crow(r, hi_e);
    for (int d0 = 0; d0 < 4; ++d0) Ow[(long)orow * LDO + d0 * 32 + r32_e] = __float2bfloat16(o[d0][r] * rli[r]); }
  asm volatile("s_waitcnt vmcnt(0) lgkmcnt(0)\n\ts_barrier" ::: "memory");
#undef GLDS16
#undef PSM
#undef FIN
#undef PVD
#undef QKT
#undef DMA_TILE
#undef WAIT_BAR
#undef RESC
}

#undef KSWZ
#undef K8SWZ
#undef SBAR
}
constexpr int NWAVES = 8;
constexpr int BATCH = 2, SEQ = 8192, DM = 4096, M = BATCH * SEQ;
constexpr int HD = 128, ATTN_W = 2048, CONV_W = 2048, NQH = 16, NKVH = 4, KV_W = 512;
constexpr int IN_COLS = 9216;
constexpr int C_Q = 0, C_K = 2048, C_V = 2560, C_CX = 3072, C_GB = 5120, C_GC = 7168;
constexpr int GRID_W = 64;
constexpr int NKEYS = 128, NEXP = 16384, PHEADS = 8, PTOPK = 16, PQ = 2048;
constexpr float EPS = 1e-6f;

constexpr size_t MiB = 1u << 20;
constexpr size_t WS_CTL = 0, CTL_ZERO_BYTES = 1 * MiB;
constexpr size_t WS_WD8  = 1 * MiB;
constexpr size_t WS_H    = 65 * MiB;
constexpr size_t WS_H8   = 193 * MiB;
constexpr size_t WS_QB   = 65 * MiB, WS_KB = 129 * MiB, WS_VB = 145 * MiB;
constexpr size_t WS_XB   = 129 * MiB;
constexpr size_t WS_X2B  = 545 * MiB;
constexpr size_t WS_G8   = 257 * MiB;
constexpr size_t WS_PROJ = 257 * MiB;
constexpr size_t WS_Y    = 545 * MiB;
constexpr size_t WS_WIN  = 673 * MiB;
constexpr size_t WS_WSC  = 745 * MiB;
constexpr size_t WS_RSS  = 761 * MiB;
constexpr size_t WS_SC   = 769 * MiB;
constexpr size_t WS_WUP8 = 929 * MiB;
constexpr size_t WS_WOUT = 897 * MiB;
constexpr size_t WS_END  = 993 * MiB;
constexpr float H6_SCALE = 1.9f, W6_SCALE = 64.f * 1.9f;
constexpr float WD_SCALE = 64.f, G_SCALE = 32.f;
static_assert(WS_H8 + 64 * MiB <= WS_G8 && WS_G8 + 256 * MiB <= WS_SC, "d_ws map");
constexpr int CW_TMO = 0, CW_CODE = 1, CW_WMAX = 64, CW_XTK = 1024  , CW_BAR = 4096;

constexpr int RING_OFF = 0, RING_BYTES = 147456;
constexpr int LDSCTL_OFF = RING_BYTES, MISC_OFF = LDSCTL_OFF + 320;
constexpr int TK_OFF = LDSCTL_OFF + 512;
constexpr int LDS_BYTES = 163840;
constexpr int H6_ROWB = 3072;
static_assert(LDSCTL_OFF + 8192 + 1024 <= LDS_BYTES, "mid-K factor table");
static_assert(TK_OFF + NWAVES * 512 <= LDS_BYTES, "LDS map");

#define GAS __attribute__((address_space(1)))
#define LAS __attribute__((address_space(3)))
typedef unsigned short bf16;
typedef unsigned v4u __attribute__((ext_vector_type(4)));
typedef float f32x4 __attribute__((ext_vector_type(4)));
typedef short bf16x8 __attribute__((ext_vector_type(8)));
typedef GAS unsigned gu32;
typedef GAS unsigned long long gu64;
#define RLX_AGENT __ATOMIC_RELAXED, __HIP_MEMORY_SCOPE_AGENT
#define LDS_WAIT() asm volatile("s_waitcnt lgkmcnt(0)" ::: "memory")
#define VM_WAIT() asm volatile("s_waitcnt vmcnt(0)" ::: "memory")
__device__ __forceinline__ unsigned long long rt() { return __builtin_amdgcn_s_memrealtime(); }
__device__ __forceinline__ unsigned f2bf(float f) { unsigned u = __builtin_bit_cast(unsigned, f); return (u + 0x7fffu + ((u >> 16) & 1u)) >> 16; }
__device__ __forceinline__ unsigned pk2(float lo, float hi) { return f2bf(lo) | (f2bf(hi) << 16); }

#define XB_TMO      128
#define XB_XCNT(j)  (256  + 64 * (j))
#define XB_XSUB(j)  (1280 + 64 * (j))
#define XB_XGEN(j)  (2304 + 64 * (j))
#define XB_TOP      3328
#define XB_TOPGEN   3392
#define XCD_BAR_WORDS 3456
#define XB_SPIN_CAP (1u << 18)

__device__ __forceinline__ unsigned xb_ld(unsigned* p)              { return __hip_atomic_load(p, __ATOMIC_RELAXED, __HIP_MEMORY_SCOPE_AGENT); }
__device__ __forceinline__ unsigned xb_add(unsigned* p, unsigned v) { return __hip_atomic_fetch_add(p, v, __ATOMIC_RELAXED, __HIP_MEMORY_SCOPE_AGENT); }
__device__ __forceinline__ unsigned xb_xcc_id() { return (unsigned)__builtin_amdgcn_s_getreg((3 << 11) | 20) & 0xFu; }
#define XB_SPIN(cond, bar) do { unsigned _sp = 0; while (cond) { __builtin_amdgcn_s_sleep(1); \
    if ((++_sp & 255u) == 0u) { if (xb_ld(&(bar)[XB_TMO])) break; if (_sp > XB_SPIN_CAP) { atomicAdd(&(bar)[XB_TMO], 1u); break; } } } } while (0)

struct XcdBarrier {
    unsigned* bar; unsigned x;
    volatile LAS unsigned* st;
};

__device__ __forceinline__ XcdBarrier xcd_barrier_post(unsigned* bar, volatile LAS unsigned* st) {
    XcdBarrier b; b.bar = bar; b.x = xb_xcc_id(); b.st = st;
    if (threadIdx.x == 0) (void)xb_add(&bar[XB_XCNT(b.x)], 1u);
    return b;
}
__device__ __forceinline__ void xcd_barrier_complete(unsigned* bar, unsigned x, unsigned& nloc, unsigned& nx) {
    const unsigned G = gridDim.x * gridDim.y * gridDim.z;
    unsigned sum, cnt, mine, sp = 0u;
    for (;;) {
        sum = 0u; cnt = 0u; mine = 0u;
#pragma unroll
        for (unsigned j = 0; j < 16; ++j) { const unsigned c = xb_ld(&bar[XB_XCNT(j)]); sum += c; cnt += (c > 0u) ? 1u : 0u; mine = (j == x) ? c : mine; }
        if (sum == G) break;
        __builtin_amdgcn_s_sleep(1);
        if ((++sp & 255u) == 0u) { if (xb_ld(&bar[XB_TMO])) break; if (sp > XB_SPIN_CAP) { atomicAdd(&bar[XB_TMO], 1u); break; } }
    }
    nloc = mine > 0u ? mine : 1u; nx = cnt > 0u ? cnt : 1u;
}

__device__ __forceinline__ void xcd_barrier(const XcdBarrier& b) {
    asm volatile("s_waitcnt vmcnt(0)" ::: "memory");
    __syncthreads();
    if (threadIdx.x == 0) {
        unsigned* bar = b.bar;
        __builtin_amdgcn_s_waitcnt(0);
        unsigned nloc = b.st[0], nx = b.st[1];
        if (nloc == 0u) { xcd_barrier_complete(bar, b.x, nloc, nx); b.st[0] = nloc; b.st[1] = nx; }
        const unsigned old = xb_add(&bar[XB_XSUB(b.x)], 1u);
        const unsigned gen = old / nloc;
        if (old + 1u == (gen + 1u) * nloc) {
            __builtin_amdgcn_fence(__ATOMIC_RELEASE, "agent");
            asm volatile("s_waitcnt vmcnt(0)" ::: "memory");
            const unsigned og = xb_add(&bar[XB_TOP], 1u);
            const unsigned tg = og / nx;
            if (og + 1u == (tg + 1u) * nx) xb_add(&bar[XB_TOPGEN], 1u);
            else XB_SPIN(xb_ld(&bar[XB_TOPGEN]) == tg, bar);
            __builtin_amdgcn_fence(__ATOMIC_ACQUIRE, "agent");
            xb_add(&bar[XB_XGEN(b.x)], 1u);
            asm volatile("s_waitcnt vmcnt(0)" ::: "memory");
        } else {
            XB_SPIN(xb_ld(&bar[XB_XGEN(b.x)]) == gen, bar);
            __builtin_amdgcn_fence(__ATOMIC_ACQUIRE, "agent");
            asm volatile("s_waitcnt vmcnt(0)" ::: "memory");
        }
    }
    __syncthreads();
}

struct Frame {
    LAS unsigned char* lds;
    volatile LAS unsigned* MISC;
    int tid, lane, wave;
    int vcu, G, cid;
};
struct Args { const float* in[15]; float* out; unsigned char* ws; int nphase; int pad; };
typedef __attribute__((address_space(4))) const unsigned char* kargp_t;
__device__ __forceinline__ kargp_t kargs() { kargp_t p = (kargp_t)__builtin_amdgcn_kernarg_segment_ptr(); asm volatile("" : "+s"(p)); return p; }
typedef const float* cfp_t; typedef float* fp_t; typedef unsigned char* ucp_t;
#define CAS4 __attribute__((address_space(4)))
__device__ __forceinline__ const float* kin(int i) { return *(const CAS4 cfp_t*)(kargs() + 8 * i); }
__device__ __forceinline__ float* kout() { return *(const CAS4 fp_t*)(kargs() + 120); }
__device__ __forceinline__ unsigned char* kws() { return *(const CAS4 ucp_t*)(kargs() + 128); }
static_assert(sizeof(Args) == 144, "Args layout");
#define T_x()            kin(0)
#define T_norm_mix_g()   kin(1)
#define T_w_in()         kin(2)
#define T_q_norm_g()     kin(3)
#define T_k_norm_g()     kin(4)
#define T_conv_w()       kin(5)
#define T_attn_out_g()   kin(6)
#define T_conv_out_g()   kin(7)
#define T_w_out()        kin(8)
#define T_norm_ffn_g()   kin(9)
#define T_w_query()      kin(10)
#define T_sub_keys()     kin(11)
#define T_w_down()       kin(12)
#define T_w_up()         kin(13)
#define T_norm_final_g() kin(14)
#define T_WD8()  ((unsigned char*)(kws() + WS_WD8))
#define T_H8()   ((unsigned char*)(kws() + WS_H8))
#define T_H()    ((bf16*)(kws() + WS_H))
#define T_G8()   ((unsigned char*)(kws() + WS_G8))
#define T_PROJ() ((bf16*)(kws() + WS_PROJ))
#define T_Y()    ((bf16*)(kws() + WS_Y))
#define T_WIN8() ((unsigned char*)(kws() + WS_WIN))
#define T_HI8()  ((unsigned char*)(kws() + WS_H))
#define T_QB()   ((bf16*)(kws() + WS_QB))
#define T_KB()   ((bf16*)(kws() + WS_KB))
#define T_VB()   ((bf16*)(kws() + WS_VB))
#define T_XB()   ((bf16*)(kws() + WS_XB))
#define T_X1B()  ((bf16*)kout())
#define T_X2B()  ((bf16*)(kws() + WS_X2B))
#define T_CMAXO() ((unsigned*)(kws() + WS_CTL + 680 * 1024))
#define T_RHO()  ((float*)(kws() + WS_CTL + 768 * 1024))
#define T_MXC()  ((float*)(kws() + WS_CTL + 832 * 1024))
#define T_SCALES() ((float*)(kws() + WS_CTL + 960 * 1024))
#define T_K8()   ((unsigned char*)(kws() + 761 * MiB))
#define T_V8()   ((unsigned char*)(kws() + 49 * MiB))
#define T_X1I8() ((unsigned char*)(kws() + WS_H))
#define T_WSC8() ((unsigned char*)(kws() + 761 * MiB))
#define T_CMAXW() ((float*)(kws() + WS_CTL + 896 * 1024))
#define T_YI8()  ((unsigned char*)(kws() + WS_H))
#define T_RS2()  ((float*)(kws() + WS_CTL + 704 * 1024))
#define T_RSA()  ((float*)(kws() + WS_CTL + 512 * 1024))
#define T_WMAX() ((unsigned*)(kws() + WS_CTL) + CW_WMAX)
#define T_CMAX() ((unsigned*)(kws() + WS_CTL + 640 * 1024))
#define T_WSC()  ((bf16*)(kws() + WS_WSC))
#define T_WUP8() ((unsigned char*)(kws() + WS_WUP8))
#define T_WOUT() ((bf16*)(kws() + WS_WOUT))
#define T_SC()   ((float*)(kws() + WS_SC))
typedef unsigned long long u64;
__device__ __forceinline__ float bflo(unsigned w) { return __uint_as_float(w << 16); }
__device__ __forceinline__ float bfhi(unsigned w) { return __uint_as_float(w & 0xffff0000u); }
__device__ __forceinline__ void unpack8(const v4u w, float (&y)[8]) { y[0] = bflo(w.x); y[1] = bfhi(w.x); y[2] = bflo(w.y); y[3] = bfhi(w.y); y[4] = bflo(w.z); y[5] = bfhi(w.z); y[6] = bflo(w.w); y[7] = bfhi(w.w); }
__device__ __forceinline__ v4u pack8(const float (&y)[8]) { v4u o; o.x = pk2(y[0], y[1]); o.y = pk2(y[2], y[3]); o.z = pk2(y[4], y[5]); o.w = pk2(y[6], y[7]); return o; }
__device__ __forceinline__ float shx(float v, int mask, int lane) { return __builtin_bit_cast(float, __builtin_amdgcn_ds_bpermute((lane ^ mask) << 2, __builtin_bit_cast(int, v))); }
__device__ __forceinline__ float wave_sum(float v, int lane) {
#pragma unroll
    for (int o = 1; o < 64; o <<= 1) v += shx(v, o, lane);
    return v;
}
__device__ __forceinline__ unsigned pk4_e4m3(float a, float b, float c, float d) { return pg8::pk4_fp8(a, b, c, d); }
__device__ __forceinline__ unsigned pk4_i8(float a, float b, float c, float d) {
    const int ia = (int)__builtin_rintf(__builtin_fminf(__builtin_fmaxf(a, -127.f), 127.f)), ib = (int)__builtin_rintf(__builtin_fminf(__builtin_fmaxf(b, -127.f), 127.f));
    const int ic = (int)__builtin_rintf(__builtin_fminf(__builtin_fmaxf(c, -127.f), 127.f)), id = (int)__builtin_rintf(__builtin_fminf(__builtin_fmaxf(d, -127.f), 127.f));
    return ((unsigned)ia & 255u) | (((unsigned)ib & 255u) << 8) | (((unsigned)ic & 255u) << 16) | ((unsigned)id << 24); }
__device__ __forceinline__ float wave_max(float v, int lane) {
#pragma unroll
    for (int o = 1; o < 64; o <<= 1) v = __builtin_fmaxf(v, shx(v, o, lane));
    return v;
}
template <bool I8> __device__ __forceinline__ unsigned pk4_q(float a, float b, float c, float d) { return I8 ? pk4_i8(a, b, c, d) : pk4_e4m3(a, b, c, d); }
__device__ __forceinline__ pg8::i32x6 cvt32_fp6(const float (&x)[32], float mul) {
    pg8::f32x16v a, b;
#pragma unroll
    for (int i = 0; i < 16; ++i) { a[i] = __builtin_fminf(__builtin_fmaxf(x[i] * mul, -7.5f), 7.5f); b[i] = __builtin_fminf(__builtin_fmaxf(x[16 + i] * mul, -7.5f), 7.5f); }
    return __builtin_amdgcn_cvt_scalef32_2xpk16_fp6_f32(a, b, 1.0f);
}
__device__ __forceinline__ void store_fp6_group(unsigned char* base, int pos, int gi, pg8::i32x6 w) {
    const int fq = gi & 3, cls = (pos >> 3) & 1;
    unsigned char* p = base + (size_t)(pos >> 8) * ((size_t)pg8::P6_NT * pg8::P6_TILE) + (size_t)(gi >> 2) * pg8::P6_TILE + (pos & 255) * pg8::P6_KT;
    const int q16 = (fq == 0) ? 0 : (fq == 1) ? 3 : (fq == 2) ? 2 : 5, q8 = ((fq < 2) != (cls != 0)) ? 1 : 4;
    *(GAS v4u*)(p + q16 * 16) = (v4u){(unsigned)w[0], (unsigned)w[1], (unsigned)w[2], (unsigned)w[3]};
    *(GAS unsigned long long*)(p + q8 * 16 + (fq & 1) * 8) = (unsigned long long)(unsigned)w[4] | ((unsigned long long)(unsigned)w[5] << 32);
}
template <bool I8> __device__ __forceinline__ void p0_transpose_item_q8(const float* W, int K, int N, unsigned char* WT, LAS float* scr, int item, int lane, float scale0, const float* rowmax, const float* kgain = nullptr, int kg_rows = 0) {
    const int nblk = N / 32, kb = item / nblk, nb = item % nblk, k0 = 64 * kb, n0 = 32 * nb;
    float ld_[32];
#pragma unroll
    for (int i = 0; i < 32; ++i) ld_[i] = W[(size_t)(k0 + 2 * i + (lane >> 5)) * N + n0 + (lane & 31)];
#pragma unroll
    for (int i = 0; i < 32; ++i) scr[(2 * i + (lane >> 5)) * 33 + (lane & 31)] = ld_[i];
    LDS_WAIT(); asm volatile("" ::: "memory");
    const int c = lane & 3;
    float kg[16];
#pragma unroll
    for (int e = 0; e < 16; ++e) kg[e] = 1.f;
    if (kgain != nullptr && k0 < kg_rows) {
#pragma unroll
        for (int e4 = 0; e4 < 4; ++e4) { const f32x4 g4 = *(const GAS f32x4*)(kgain + k0 + 16 * c + 4 * e4); kg[4 * e4] = g4.x; kg[4 * e4 + 1] = g4.y; kg[4 * e4 + 2] = g4.z; kg[4 * e4 + 3] = g4.w; } }
#pragma unroll
    for (int j = 0; j < 2; ++j) { const int n = (lane >> 2) + 16 * j; const LAS float* s = scr + (16 * c) * 33 + n;
        float scale = scale0; if (I8) { const float mx_ = rowmax[n0 + n]; scale = mx_ > 0.f ? 127.f / mx_ : 0.f; }
        v4u o;
        o.x = pk4_q<I8>(s[0 * 33] * kg[0] * scale, s[1 * 33] * kg[1] * scale, s[2 * 33] * kg[2] * scale, s[3 * 33] * kg[3] * scale); o.y = pk4_q<I8>(s[4 * 33] * kg[4] * scale, s[5 * 33] * kg[5] * scale, s[6 * 33] * kg[6] * scale, s[7 * 33] * kg[7] * scale);
        o.z = pk4_q<I8>(s[8 * 33] * kg[8] * scale, s[9 * 33] * kg[9] * scale, s[10 * 33] * kg[10] * scale, s[11 * 33] * kg[11] * scale); o.w = pk4_q<I8>(s[12 * 33] * kg[12] * scale, s[13 * 33] * kg[13] * scale, s[14 * 33] * kg[14] * scale, s[15 * 33] * kg[15] * scale);
        *(GAS v4u*)(WT + (size_t)(n0 + n) * K + k0 + 16 * c) = o; }
    LDS_WAIT(); asm volatile("" ::: "memory");
}
__device__ __forceinline__ void p0_transpose_item(const float* W, int K, int N, bf16* WT, LAS float* scr, int item, int lane, const float* kgain, int kg_rows) {
    const int nblk = N / 32, kb = item / nblk, nb = item % nblk, k0 = 64 * kb, n0 = 32 * nb;
    float ld_[32];
#pragma unroll
    for (int i = 0; i < 32; ++i) ld_[i] = W[(size_t)(k0 + 2 * i + (lane >> 5)) * N + n0 + (lane & 31)];
#pragma unroll
    for (int i = 0; i < 32; ++i) scr[(2 * i + (lane >> 5)) * 33 + (lane & 31)] = ld_[i];
    LDS_WAIT(); asm volatile("" ::: "memory");
    const int c = lane & 7;
    f32x4 g0 = {1.f, 1.f, 1.f, 1.f}, g1 = g0;
    if (kgain != nullptr && k0 < kg_rows) { g0 = *(const GAS f32x4*)(kgain + k0 + 8 * c); g1 = *(const GAS f32x4*)(kgain + k0 + 8 * c + 4); }
#pragma unroll
    for (int j = 0; j < 4; ++j) { const int n = (lane >> 3) + 8 * j; const LAS float* s = scr + (8 * c) * 33 + n;
        v4u o; o.x = pk2(s[0 * 33] * g0.x, s[1 * 33] * g0.y); o.y = pk2(s[2 * 33] * g0.z, s[3 * 33] * g0.w); o.z = pk2(s[4 * 33] * g1.x, s[5 * 33] * g1.y); o.w = pk2(s[6 * 33] * g1.z, s[7 * 33] * g1.w);
        *(GAS v4u*)(WT + (size_t)(n0 + n) * K + k0 + 8 * c) = o; }
    LDS_WAIT(); asm volatile("" ::: "memory");
}
template <bool FP8COPY> __device__ __forceinline__ void rms_row_to_bf16(const float* xrow, const float* g, bf16* orow, unsigned char* orow8, int lane) {
    const GAS f32x4* xr = (const GAS f32x4*)xrow + lane;
    f32x4 v[16]; float s = 0.f;
#pragma unroll
    for (int j = 0; j < 16; ++j) { v[j] = xr[64 * j]; s += (v[j].x * v[j].x + v[j].y * v[j].y) + (v[j].z * v[j].z + v[j].w * v[j].w); }
    const float r = 1.0f / sqrtf(wave_sum(s, lane) * (1.f / DM) + EPS);
    const GAS f32x4* gr = (const GAS f32x4*)g + lane;
    GAS u64* o8 = (GAS u64*)orow + lane;
#pragma unroll
    for (int j = 0; j < 16; ++j) { const f32x4 gg = gr[64 * j];
        const float y0 = v[j].x * r * gg.x, y1 = v[j].y * r * gg.y, y2 = v[j].z * r * gg.z, y3 = v[j].w * r * gg.w;
        o8[64 * j] = (u64)pk2(y0, y1) | ((u64)pk2(y2, y3) << 32);
        if (FP8COPY) ((GAS unsigned*)orow8)[lane + 64 * j] = pk4_e4m3(y0, y1, y2, y3); }
}
__device__ __forceinline__ void rms_row_to_i8(const float* xrow, const float* g, unsigned char* orow8, float* rs, bf16* xbrow, int lane) {
    const GAS f32x4* xr = (const GAS f32x4*)xrow + lane;
    f32x4 v[16]; float s = 0.f;
#pragma unroll
    for (int j = 0; j < 16; ++j) { v[j] = xr[64 * j]; s += (v[j].x * v[j].x + v[j].y * v[j].y) + (v[j].z * v[j].z + v[j].w * v[j].w);
        ((GAS u64*)xbrow)[lane + 64 * j] = (u64)pk2(v[j].x, v[j].y) | ((u64)pk2(v[j].z, v[j].w) << 32); }
    const float r = 1.0f / sqrtf(wave_sum(s, lane) * (1.f / DM) + EPS);
    const GAS f32x4* gr = (const GAS f32x4*)g + lane;
    float mx = 0.f;
#pragma unroll
    for (int j = 0; j < 16; ++j) { const f32x4 gg = gr[64 * j]; v[j].x = v[j].x * r * gg.x; v[j].y = v[j].y * r * gg.y; v[j].z = v[j].z * r * gg.z; v[j].w = v[j].w * r * gg.w;
        mx = __builtin_fmaxf(mx, __builtin_fmaxf(__builtin_fmaxf(__builtin_fabsf(v[j].x), __builtin_fabsf(v[j].y)), __builtin_fmaxf(__builtin_fabsf(v[j].z), __builtin_fabsf(v[j].w)))); }
    mx = wave_max(mx, lane);
    const float sc = mx > 0.f ? 127.f / mx : 0.f;
#pragma unroll
    for (int j = 0; j < 16; ++j) ((GAS unsigned*)orow8)[lane + 64 * j] = pk4_i8(v[j].x * sc, v[j].y * sc, v[j].z * sc, v[j].w * sc);
    if (lane == 0) *rs = mx * (1.f / 127.f);
}
__device__ __forceinline__ void rms_rowb_to_h2(const bf16* xrow, const float* g, float* rstd_out, unsigned char* h6base, int pos, int lane, unsigned char* x8row, const float h6s) {
    float s = 0.f, mx = 0.f;
#pragma unroll
    for (int j = 0; j < 8; ++j) { const v4u w = *(const GAS v4u*)(xrow + 8 * (lane + 64 * j)); float t8[8]; unpack8(w, t8);
#pragma unroll
        for (int e = 0; e < 8; ++e) { s += t8[e] * t8[e]; mx = __builtin_fmaxf(mx, __builtin_fabsf(t8[e])); } }
    const float r = 1.0f / sqrtf(wave_sum(s, lane) * (1.f / DM) + EPS);
    mx = wave_max(mx, lane);
    if (lane == 0) *rstd_out = r * mx * (1.f / 127.f);
    { const float sc = mx > 0.f ? 127.f / mx : 0.f;
#pragma unroll
      for (int j = 0; j < 8; ++j) { int col = 8 * (lane + 64 * j); asm volatile("" : "+v"(col)); const v4u w = *(const GAS v4u*)(xrow + col); float t8[8]; unpack8(w, t8);
          *(GAS u64*)(x8row + col) = (u64)pk4_i8(t8[0] * sc, t8[1] * sc, t8[2] * sc, t8[3] * sc) | ((u64)pk4_i8(t8[4] * sc, t8[5] * sc, t8[6] * sc, t8[7] * sc) << 32); } }
#pragma unroll
    for (int jj = 0; jj < 2; ++jj) { const int gi = lane + 64 * jj; float y[32];
#pragma unroll
        for (int q = 0; q < 4; ++q) { const v4u w = *(const GAS v4u*)(xrow + 32 * gi + 8 * q); float t8[8]; unpack8(w, t8);
            const f32x4 g0 = *(const GAS f32x4*)(g + 32 * gi + 8 * q), g1 = *(const GAS f32x4*)(g + 32 * gi + 8 * q + 4);
            y[8 * q + 0] = t8[0] * r * g0.x; y[8 * q + 1] = t8[1] * r * g0.y; y[8 * q + 2] = t8[2] * r * g0.z; y[8 * q + 3] = t8[3] * r * g0.w;
            y[8 * q + 4] = t8[4] * r * g1.x; y[8 * q + 5] = t8[5] * r * g1.y; y[8 * q + 6] = t8[6] * r * g1.z; y[8 * q + 7] = t8[7] * r * g1.w; }
        store_fp6_group(h6base, pos, gi, cvt32_fp6(y, h6s)); }
}
__device__ __forceinline__ void rms_rowb_to_f32(const bf16* xrow, const float* g, float* orow, int lane) {
    float v[8][8]; float s = 0.f;
#pragma unroll
    for (int j = 0; j < 8; ++j) { const v4u w = *(const GAS v4u*)(xrow + 8 * (lane + 64 * j)); unpack8(w, v[j]);
#pragma unroll
        for (int e = 0; e < 8; ++e) s += v[j][e] * v[j][e]; }
    const float r = 1.0f / sqrtf(wave_sum(s, lane) * (1.f / DM) + EPS);
#pragma unroll
    for (int j = 0; j < 8; ++j) { const int col = 8 * (lane + 64 * j);
        const f32x4 g0 = *(const GAS f32x4*)(g + col), g1 = *(const GAS f32x4*)(g + col + 4);
        f32x4 o0, o1; o0.x = v[j][0] * r * g0.x; o0.y = v[j][1] * r * g0.y; o0.z = v[j][2] * r * g0.z; o0.w = v[j][3] * r * g0.w; o1.x = v[j][4] * r * g1.x; o1.y = v[j][5] * r * g1.y; o1.z = v[j][6] * r * g1.z; o1.w = v[j][7] * r * g1.w;
        *(GAS f32x4*)(orow + col) = o0; *(GAS f32x4*)(orow + col + 4) = o1; }
}
__device__ __forceinline__ void rms_row_inplace(float* xrow, const float* g, int lane) {
    GAS f32x4* xr = (GAS f32x4*)xrow + lane;
    f32x4 v[16]; float s = 0.f;
#pragma unroll
    for (int j = 0; j < 16; ++j) { v[j] = xr[64 * j]; s += (v[j].x * v[j].x + v[j].y * v[j].y) + (v[j].z * v[j].z + v[j].w * v[j].w); }
    const float r = 1.0f / sqrtf(wave_sum(s, lane) * (1.f / DM) + EPS);
    const GAS f32x4* gr = (const GAS f32x4*)g + lane;
#pragma unroll
    for (int j = 0; j < 16; ++j) { const f32x4 gg = gr[64 * j]; f32x4 o; o.x = v[j].x * r * gg.x; o.y = v[j].y * r * gg.y; o.z = v[j].z * r * gg.z; o.w = v[j].w * r * gg.w; xr[64 * j] = o; }
}
__device__ __forceinline__ void p0_premul_item(Frame& F, int item, const float* sub_keys, const float* w_query, bf16* WSC, const float* gk) {
    constexpr int LDP = 132;
    LAS float* Ks = (LAS float*)(F.lds + RING_OFF);
    LAS float* Ws = Ks + 128 * LDP;
    const int hp = item >> 6, k0 = (item & 63) * 64, tid = F.tid;
    const float* kg = sub_keys + (size_t)hp * 128 * 128;
#pragma unroll
    for (int i = 0; i < 8; ++i) { const int e = tid + 512 * i, r = e >> 5, c4 = e & 31; const f32x4 v = *(const GAS f32x4*)(kg + (size_t)r * 128 + c4 * 4); *(LAS f32x4*)(Ks + r * LDP + c4 * 4) = v; }
#pragma unroll
    for (int i = 0; i < 4; ++i) { const int e = tid + 512 * i, r = e >> 5, c4 = e & 31; const f32x4 v = *(const GAS f32x4*)(w_query + (size_t)(k0 + r) * PQ + hp * 128 + c4 * 4); *(LAS f32x4*)(Ws + r * LDP + c4 * 4) = v; }
    __syncthreads();
    const int lane = tid & 63, w = tid >> 6, r = lane & 15, q = lane >> 4;
    pg8::f32x4 acc[4];
#pragma unroll
    for (int n = 0; n < 4; ++n) acc[n] = (pg8::f32x4){0.f, 0.f, 0.f, 0.f};
#pragma unroll
    for (int st = 0; st < 4; ++st) {
        const f32x4 a0 = *(const LAS f32x4*)(Ks + (16 * w + r) * LDP + 32 * st + 8 * q), a1 = *(const LAS f32x4*)(Ks + (16 * w + r) * LDP + 32 * st + 8 * q + 4);
        v4u aw = {pk2(a0.x, a0.y), pk2(a0.z, a0.w), pk2(a1.x, a1.y), pk2(a1.z, a1.w)}; const pg8::bf16x8 af = __builtin_bit_cast(pg8::bf16x8, aw);
#pragma unroll
        for (int n = 0; n < 4; ++n) {
            const f32x4 b0 = *(const LAS f32x4*)(Ws + (16 * n + r) * LDP + 32 * st + 8 * q), b1 = *(const LAS f32x4*)(Ws + (16 * n + r) * LDP + 32 * st + 8 * q + 4);
            v4u bw = {pk2(b0.x, b0.y), pk2(b0.z, b0.w), pk2(b1.x, b1.y), pk2(b1.z, b1.w)}; const pg8::bf16x8 bf = __builtin_bit_cast(pg8::bf16x8, bw);
            acc[n] = __builtin_amdgcn_mfma_f32_16x16x32_bf16(af, bf, acc[n], 0, 0, 0); }
    }
#pragma unroll
    for (int n = 0; n < 4; ++n) { const float gg = gk[k0 + 16 * n + r];
#pragma unroll
        for (int e = 0; e < 4; ++e) WSC[(size_t)(hp * 128 + 16 * w + 4 * q + e) * DM + k0 + 16 * n + r] = (bf16)f2bf(acc[n][e] * gg); }
    __syncthreads();
}
__device__ __forceinline__ float peer_scale(const float* sp, int k) {
    float a = 0.f;
    for (int i = 0; i < 64; ++i) a += sp[64 * k + i];
    const float rms = sqrtf(a * (k == 2 ? 1.f / DM : 1.f / 16384.f));
    return rms > 0.f ? (k == 1 ? 0.5f : 1.9f) / rms : 1.f;
}
#define PEER_SCALE(k) __uint_as_float((unsigned)__builtin_amdgcn_readfirstlane((int)F.MISC[16 + (k)]))
__device__ __forceinline__ void p0a_absmax(Frame& F) {
    const float* w_in = T_w_in(); constexpr int NCG = IN_COLS / 4, RPT = 56;
    const int t = F.vcu * 512 + F.tid;
    if (t < RPT * NCG) { const int cg = t % NCG, r0 = t / NCG;
        f32x4 m = {0.f, 0.f, 0.f, 0.f};
        for (int r = r0; r < DM; r += 8 * RPT) {
            f32x4 a[8];
#pragma unroll
            for (int u = 0; u < 8; ++u) { const int rr = r + u * RPT; a[u] = *(const GAS f32x4*)(w_in + (size_t)(rr < DM ? rr : r) * IN_COLS + 4 * cg); }
#pragma unroll
            for (int u = 0; u < 8; ++u) { m.x = __builtin_fmaxf(m.x, __builtin_fabsf(a[u].x)); m.y = __builtin_fmaxf(m.y, __builtin_fabsf(a[u].y)); m.z = __builtin_fmaxf(m.z, __builtin_fabsf(a[u].z)); m.w = __builtin_fmaxf(m.w, __builtin_fabsf(a[u].w)); } }
        unsigned* cm = T_CMAX() + 4 * cg;
        __hip_atomic_fetch_max(cm + 0, __float_as_uint(m.x), __ATOMIC_RELAXED, __HIP_MEMORY_SCOPE_AGENT); __hip_atomic_fetch_max(cm + 1, __float_as_uint(m.y), __ATOMIC_RELAXED, __HIP_MEMORY_SCOPE_AGENT);
        __hip_atomic_fetch_max(cm + 2, __float_as_uint(m.z), __ATOMIC_RELAXED, __HIP_MEMORY_SCOPE_AGENT); __hip_atomic_fetch_max(cm + 3, __float_as_uint(m.w), __ATOMIC_RELAXED, __HIP_MEMORY_SCOPE_AGENT); }
    { const float* w_out = T_w_out(); const float* ag = T_attn_out_g(); const int cg = t & 1023, r0 = t >> 10;
      if (r0 < 128) {
        f32x4 m = {0.f, 0.f, 0.f, 0.f};
        for (int r = r0; r < DM; r += 8 * 128) {
            f32x4 a[8]; float gg[8];
#pragma unroll
            for (int u = 0; u < 8; ++u) { const int rr = r + u * 128; a[u] = *(const GAS f32x4*)(w_out + (size_t)rr * DM + 4 * cg); gg[u] = rr < ATTN_W ? __builtin_fabsf(ag[rr]) : 1.f; }
#pragma unroll
            for (int u = 0; u < 8; ++u) { m.x = __builtin_fmaxf(m.x, __builtin_fabsf(a[u].x) * gg[u]); m.y = __builtin_fmaxf(m.y, __builtin_fabsf(a[u].y) * gg[u]); m.z = __builtin_fmaxf(m.z, __builtin_fabsf(a[u].z) * gg[u]); m.w = __builtin_fmaxf(m.w, __builtin_fabsf(a[u].w) * gg[u]); } }
        unsigned* cm = T_CMAXO() + 4 * cg;
        __hip_atomic_fetch_max(cm + 0, __float_as_uint(m.x), __ATOMIC_RELAXED, __HIP_MEMORY_SCOPE_AGENT); __hip_atomic_fetch_max(cm + 1, __float_as_uint(m.y), __ATOMIC_RELAXED, __HIP_MEMORY_SCOPE_AGENT);
        __hip_atomic_fetch_max(cm + 2, __float_as_uint(m.z), __ATOMIC_RELAXED, __HIP_MEMORY_SCOPE_AGENT); __hip_atomic_fetch_max(cm + 3, __float_as_uint(m.w), __ATOMIC_RELAXED, __HIP_MEMORY_SCOPE_AGENT); } }
    if (F.vcu < 64) {
        const float* wd = T_w_down(); const float* wu = T_w_up(); const float* gf = T_norm_ffn_g();
        float sd = 0.f, su = 0.f, sg = 0.f;
        if (F.tid < 256) { const size_t idx = (size_t)F.vcu * ((size_t)NEXP * DM / 64) + F.tid; const float a = wd[idx], c = wu[idx]; sd = a * a; su = c * c; }
        if (F.tid < DM / 64) { const float a = gf[F.vcu * (DM / 64) + F.tid]; sg = a * a; }
        sd = wave_sum(sd, F.lane); su = wave_sum(su, F.lane); sg = wave_sum(sg, F.lane);
        LAS float* red = (LAS float*)(F.lds + RING_OFF);
        if (F.lane == 0) { red[F.wave] = sd; red[8 + F.wave] = su; red[16 + F.wave] = sg; }
        LDS_WAIT(); __syncthreads();
        if (F.tid == 0) { float a = 0.f, c = 0.f, e = 0.f;
            for (int w = 0; w < NWAVES; ++w) { a += red[w]; c += red[8 + w]; e += red[16 + w]; }
            float* sp = T_SCALES(); sp[F.vcu] = a; sp[64 + F.vcu] = c; sp[128 + F.vcu] = e; }
        __syncthreads();
    }
}
__device__ __forceinline__ void p0_prologue(Frame& F) {
    const int gw = F.vcu * NWAVES + F.wave, NGW = F.G * NWAVES;
    LAS float* scr = (LAS float*)(F.lds + RING_OFF + F.wave * 16384);
    constexpr int I_IN = (DM / 64) * (IN_COLS / 32);
    { const float* w_in = T_w_in(); unsigned char* WIN8 = T_WIN8();
      for (int it = gw; it < I_IN; it += NGW) p0_transpose_item_q8<true>(w_in, DM, IN_COLS, WIN8, scr, it, F.lane, 1.0f, (const float*)T_CMAX()); }
    { const float* x = T_x(); const float* g = T_norm_mix_g(); unsigned char* HI8 = T_HI8(); float* rsA = T_RSA(); bf16* XB = T_XB();
      for (int m = gw; m < M; m += NGW) rms_row_to_i8(x + (size_t)m * DM, g, HI8 + (size_t)m * DM, rsA + m, XB + (size_t)m * DM, F.lane); }
}
__device__ __forceinline__ void side_weight_copies(Frame& F) {
    { unsigned z_ = 0u; asm volatile("" : "+v"(z_)); const int t_ = (F.wave << 6) | (int)__builtin_amdgcn_mbcnt_hi(~0u, __builtin_amdgcn_mbcnt_lo(~0u, z_)); F.tid = t_; F.lane = t_ & 63; }
    const int gw = F.vcu * NWAVES + F.wave, NGW = F.G * NWAVES;
    __syncthreads();
    { const float* sk = T_sub_keys(); const float* wq = T_w_query(); bf16* wsc = T_WSC(); const float* gk = T_norm_ffn_g();
      for (int it = F.vcu; it < 16 * 64; it += F.G) p0_premul_item(F, it, sk, wq, wsc, gk); }
    LAS float* scr = (LAS float*)(F.lds + RING_OFF + F.wave * 16384);
    constexpr int I_OUT = (DM / 64) * (DM / 32), I_UP = (NEXP / 64) * (DM / 32);
    { const float* w_out = T_w_out(); bf16* WOUT = T_WOUT(); const float* ag = T_attn_out_g();
      for (int it = gw; it < I_OUT; it += NGW) p0_transpose_item_q8<true>(w_out, DM, DM, (unsigned char*)WOUT, scr, it, F.lane, 1.0f, (const float*)T_CMAXO(), ag, ATTN_W); }
    { const float* w_up = T_w_up(); unsigned char* WUP8 = T_WUP8(); const float wus = PEER_SCALE(1);
      for (int it = gw; it < I_UP; it += NGW) p0_transpose_item_q8<false>(w_up, NEXP, DM, WUP8, scr, it, F.lane, wus, nullptr); }
    { const float w6s = PEER_SCALE(0); const float* w_down = T_w_down(); unsigned char* WD6 = T_WD8(); const size_t n32 = (size_t)NEXP * DM / 32, stride = (size_t)F.G * 512;
      for (size_t i = (size_t)F.vcu * 512 + F.tid; i < n32; i += 2 * stride) {
          f32x4 q[2][8];
#pragma unroll
          for (int u = 0; u < 2; ++u)
#pragma unroll
              for (int j = 0; j < 8; ++j) q[u][j] = *(const GAS f32x4*)(w_down + (i + u * stride) * 32 + 4 * j);
#pragma unroll
          for (int u = 0; u < 2; ++u) { float y[32];
#pragma unroll
              for (int j = 0; j < 8; ++j) { y[4 * j] = q[u][j].x; y[4 * j + 1] = q[u][j].y; y[4 * j + 2] = q[u][j].z; y[4 * j + 3] = q[u][j].w; }
              const size_t gidx = i + u * stride; const int e_ = (int)(gidx >> 7), c_ = e_ & 31, rho_ = 16 * ((c_ >> 2) & 1) + 4 * (c_ >> 3) + (c_ & 3);
                  store_fp6_group(WD6, (e_ & ~31) + rho_, (int)(gidx & 127), cvt32_fp6(y, w6s)); } } }
    VM_WAIT(); LDS_WAIT();
    __syncthreads();
}
__device__ __forceinline__ void p3b_quant_token(Frame& F, int t, const bf16* Y, unsigned char* YI8, const float* mxc_in, float* rs, float* rho) {
    const int lane = F.lane;
    const bf16* yrow = Y + (size_t)t * DM;
    float v[4][8]; float ss = 0.f;
#pragma unroll
    for (int i = 0; i < 4; ++i) { const v4u w = *(const GAS v4u*)(yrow + 8 * (lane + 64 * i)); unpack8(w, v[i]);
#pragma unroll
        for (int e = 0; e < 8; ++e) ss += v[i][e] * v[i][e]; }
    const float r = 1.0f / sqrtf(wave_sum(ss, lane) * (1.f / ATTN_W) + EPS);
    float mxa = 0.f;
#pragma unroll
    for (int i = 0; i < 4; ++i)
#pragma unroll
        for (int e = 0; e < 8; ++e) { v[i][e] *= r; mxa = __builtin_fmaxf(mxa, __builtin_fabsf(v[i][e])); }
    mxa = wave_max(mxa, lane);
    float mxc = mxc_in[t]; if (!(mxc > 0.f)) mxc = mxa;
    const float sa = mxa > 0.f ? 127.f / mxa : 0.f;
    unsigned char* orow = YI8 + (size_t)t * DM;
#pragma unroll
    for (int i = 0; i < 4; ++i) { int col = 8 * (lane + 64 * i); asm volatile("" : "+v"(col));
        *(GAS u64*)(orow + col) = (u64)pk4_i8(v[i][0] * sa, v[i][1] * sa, v[i][2] * sa, v[i][3] * sa) | ((u64)pk4_i8(v[i][4] * sa, v[i][5] * sa, v[i][6] * sa, v[i][7] * sa) << 32); }
    if (lane == 0) { rs[t] = mxc * (1.f / 127.f); rho[t] = mxc > 0.f ? mxa / mxc : 0.f; }
}
__device__ __forceinline__ void wsc_quant_row(const bf16* wrow, unsigned char* orow, float* cmax, int lane) {
    float v[8][8]; float mx = 0.f;
#pragma unroll
    for (int i = 0; i < 8; ++i) { const v4u w = *(const GAS v4u*)(wrow + 8 * (lane + 64 * i)); unpack8(w, v[i]);
#pragma unroll
        for (int e = 0; e < 8; ++e) mx = __builtin_fmaxf(mx, __builtin_fabsf(v[i][e])); }
    mx = wave_max(mx, lane);
    const float sc = mx > 0.f ? 127.f / mx : 0.f;
#pragma unroll
    for (int i = 0; i < 8; ++i) { int col = 8 * (lane + 64 * i); asm volatile("" : "+v"(col));
        *(GAS u64*)(orow + col) = (u64)pk4_i8(v[i][0] * sc, v[i][1] * sc, v[i][2] * sc, v[i][3] * sc) | ((u64)pk4_i8(v[i][4] * sc, v[i][5] * sc, v[i][6] * sc, v[i][7] * sc) << 32); }
    if (lane == 0) *cmax = mx;
}
constexpr float K8_CLIP = 4.5f;
__device__ __forceinline__ float k8_max(const float* k_norm_g, int lane) { return K8_CLIP * wave_max(__builtin_fmaxf(__builtin_fabsf(k_norm_g[lane]), __builtin_fabsf(k_norm_g[64 + lane])), lane); }
__device__ __forceinline__ void p2_k_token(Frame& F, int t, const float (&inv)[8], bf16* PROJ, const float* k_norm_g, unsigned char* K8, const float sk) {
    const int lane = F.lane, lp = lane & 15, s = t & (SEQ - 1);
    const bool colpart = (lp >> 3) != 0, first = ((lp >> 2) & 1) == 0;
    const float pos = (float)(colpart ? (s & (GRID_W - 1)) : (s / GRID_W));
    float cs[8], sn[8];
#pragma unroll
    for (int e = 0; e < 8; ++e) { const float ang = pos * inv[e]; float rev = ang * 0.15915494309189535f; rev = rev - floorf(rev); cs[e] = __builtin_amdgcn_cosf(rev); sn[e] = __builtin_amdgcn_sinf(rev); }
    bf16* p = PROJ + (size_t)t * IN_COLS + C_K + 8 * lane;
    const v4u raw = *(const GAS v4u*)p;
    float y[8]; unpack8(raw, y);
    float ss = 0.f;
#pragma unroll
    for (int e = 0; e < 8; ++e) ss += y[e] * y[e];
    ss += shx(ss, 1, lane); ss += shx(ss, 2, lane); ss += shx(ss, 4, lane); ss += shx(ss, 8, lane);
    const float r = 1.0f / sqrtf(ss * (1.f / HD) + EPS);
    const f32x4 g0 = *(const GAS f32x4*)(k_norm_g + 8 * lp), g1 = *(const GAS f32x4*)(k_norm_g + 8 * lp + 4);
    const float gg[8] = {g0.x, g0.y, g0.z, g0.w, g1.x, g1.y, g1.z, g1.w};
    float o[8];
#pragma unroll
    for (int e = 0; e < 8; ++e) y[e] = y[e] * r * gg[e];
#pragma unroll
    for (int e = 0; e < 8; ++e) { const float pr = shx(y[e], 4, lane); o[e] = y[e] * cs[e] + (first ? -pr : pr) * sn[e]; }
    { const int b_ = t / SEQ, head = lane >> 4;
      *(GAS u64*)(K8 + ((size_t)(b_ * NKVH + head) * SEQ + s) * HD + 8 * lp) = (u64)pk4_i8(o[0] * sk, o[1] * sk, o[2] * sk, o[3] * sk) | ((u64)pk4_i8(o[4] * sk, o[5] * sk, o[6] * sk, o[7] * sk) << 32); }
}
__device__ __forceinline__ void p2_conv_run(Frame& F, int t0, int n, const bf16* PROJ, unsigned char* YI8, float* mxc_out, const float* conv_w, const float* conv_out_g) {
    const int lane = F.lane;
    float uL[4][8], u0[4][8];
    { const int s0 = t0 & (SEQ - 1); const bool hasL = s0 != 0; const float fL = hasL ? 1.f : 0.f;
      const bf16* r0 = PROJ + (size_t)t0 * IN_COLS; const bf16* rL = hasL ? r0 - IN_COLS : r0;
#pragma unroll
      for (int i = 0; i < 4; ++i) { const int col = 8 * (lane + 64 * i);
          const v4u cxa = *(const GAS v4u*)(rL + C_CX + col), gca = *(const GAS v4u*)(rL + C_GC + col), cxb = *(const GAS v4u*)(r0 + C_CX + col), gcb = *(const GAS v4u*)(r0 + C_GC + col);
          float a[8], b[8], c[8], d[8]; unpack8(cxa, a); unpack8(gca, b); unpack8(cxb, c); unpack8(gcb, d);
#pragma unroll
          for (int e = 0; e < 8; ++e) { uL[i][e] = a[e] * b[e] * fL; u0[i][e] = c[e] * d[e]; } } }
    for (int k = 0; k < n; ++k) {
        const int t = t0 + k, s = t & (SEQ - 1); const bool hasR = s != SEQ - 1; const float fR = hasR ? 1.f : 0.f;
        const bf16* r0 = PROJ + (size_t)t * IN_COLS; const bf16* rR = hasR ? r0 + IN_COLS : r0;
        v4u cxR[4], gcR[4], gbr[4];
#pragma unroll
        for (int i = 0; i < 4; ++i) { const int col = 8 * (lane + 64 * i); cxR[i] = *(const GAS v4u*)(rR + C_CX + col); gcR[i] = *(const GAS v4u*)(rR + C_GC + col); gbr[i] = *(const GAS v4u*)(r0 + C_GB + col); }
        float o[4][8]; float ss = 0.f;
#pragma unroll
        for (int i = 0; i < 4; ++i) {
            int col = 8 * (lane + 64 * i); asm volatile("" : "+v"(col));
            float a[8], b[8], gb[8]; unpack8(cxR[i], a); unpack8(gcR[i], b); unpack8(gbr[i], gb);
            const float* w = conv_w + col;
            const f32x4 w0a = *(const GAS f32x4*)w, w0b = *(const GAS f32x4*)(w + 4), w1a = *(const GAS f32x4*)(w + CONV_W), w1b = *(const GAS f32x4*)(w + CONV_W + 4), w2a = *(const GAS f32x4*)(w + 2 * CONV_W), w2b = *(const GAS f32x4*)(w + 2 * CONV_W + 4);
            const float w0[8] = {w0a.x, w0a.y, w0a.z, w0a.w, w0b.x, w0b.y, w0b.z, w0b.w}, w1[8] = {w1a.x, w1a.y, w1a.z, w1a.w, w1b.x, w1b.y, w1b.z, w1b.w}, w2[8] = {w2a.x, w2a.y, w2a.z, w2a.w, w2b.x, w2b.y, w2b.z, w2b.w};
#pragma unroll
            for (int e = 0; e < 8; ++e) { const float uR = a[e] * b[e] * fR; const float cv = gb[e] * (uL[i][e] * w0[e] + u0[i][e] * w1[e] + uR * w2[e]); o[i][e] = cv; ss += cv * cv; uL[i][e] = u0[i][e]; u0[i][e] = uR; }
            asm volatile("" : "+v"(ss) :: "memory"); __builtin_amdgcn_sched_barrier(0);
        }
        const float r = 1.0f / sqrtf(wave_sum(ss, lane) * (1.f / CONV_W) + EPS);
        float mx = 0.f;
#pragma unroll
        for (int i = 0; i < 4; ++i) { int col = 8 * (lane + 64 * i); asm volatile("" : "+v"(col));
            const f32x4 g0 = *(const GAS f32x4*)(conv_out_g + col), g1 = *(const GAS f32x4*)(conv_out_g + col + 4);
            const float gg[8] = {g0.x, g0.y, g0.z, g0.w, g1.x, g1.y, g1.z, g1.w};
#pragma unroll
            for (int e = 0; e < 8; ++e) { o[i][e] = o[i][e] * r * gg[e]; mx = __builtin_fmaxf(mx, __builtin_fabsf(o[i][e])); } }
        mx = wave_max(mx, lane);
        const float sc = mx > 0.f ? 127.f / mx : 0.f;
        unsigned char* yrow = YI8 + (size_t)t * DM + ATTN_W;
#pragma unroll
        for (int i = 0; i < 4; ++i) { int col = 8 * (lane + 64 * i); asm volatile("" : "+v"(col));
            *(GAS u64*)(yrow + col) = (u64)pk4_i8(o[i][0] * sc, o[i][1] * sc, o[i][2] * sc, o[i][3] * sc) | ((u64)pk4_i8(o[i][4] * sc, o[i][5] * sc, o[i][6] * sc, o[i][7] * sc) << 32); }
        if (lane == 0) mxc_out[t] = mx;
    }
}
__device__ __forceinline__ void p3b_token(Frame& F, int t, bf16* Y, const float* attn_out_g) {
    const int lane = F.lane;
    bf16* yrow = Y + (size_t)t * DM;
    float v[4][8]; float ss = 0.f;
#pragma unroll
    for (int i = 0; i < 4; ++i) { const v4u w = *(const GAS v4u*)(yrow + 8 * (lane + 64 * i)); unpack8(w, v[i]);
#pragma unroll
        for (int e = 0; e < 8; ++e) ss += v[i][e] * v[i][e]; }
    const float r = 1.0f / sqrtf(wave_sum(ss, lane) * (1.f / ATTN_W) + EPS);
#pragma unroll
    for (int i = 0; i < 4; ++i) { int col = 8 * (lane + 64 * i); asm volatile("" : "+v"(col));
        const f32x4 g0 = *(const GAS f32x4*)(attn_out_g + col), g1 = *(const GAS f32x4*)(attn_out_g + col + 4);
        const float gg[8] = {g0.x, g0.y, g0.z, g0.w, g1.x, g1.y, g1.z, g1.w};
        float y[8];
#pragma unroll
        for (int e = 0; e < 8; ++e) y[e] = v[i][e] * r * gg[e];
        *(GAS v4u*)(yrow + col) = pack8(y); }
}
__device__ __forceinline__ unsigned fkey(float f) { const unsigned u = __float_as_uint(f); return u ^ ((u >> 31) ? 0xFFFFFFFFu : 0x80000000u); }
__device__ __forceinline__ int popc64(u64 m) { return __builtin_popcountll(m); }
__device__ __forceinline__ int lanes_below(u64 m) { return (int)__builtin_amdgcn_mbcnt_hi((unsigned)(m >> 32), __builtin_amdgcn_mbcnt_lo((unsigned)m, 0u)); }
template <int NS> __device__ __forceinline__ unsigned topk_thresh(const unsigned (&k)[NS]) {
    unsigned T = 0u;
    for (int bit = 31; bit >= 0; --bit) {
        const unsigned cand = T | (1u << bit); int cnt = 0;
#pragma unroll
        for (int j = 0; j < NS; ++j) cnt += popc64(__ballot(k[j] >= cand));
        if (cnt >= PTOPK) { T = cand; if (cnt == PTOPK) break; }
    }
    return T;
}
template <int NS> __device__ __forceinline__ void topk_select(const unsigned (&k)[NS], unsigned T, bool (&sel)[NS], int (&pos)[NS]) {
    int ngt = 0;
#pragma unroll
    for (int j = 0; j < NS; ++j) ngt += popc64(__ballot(k[j] > T));
    int need = PTOPK - ngt, eqbase = 0, base = 0;
#pragma unroll
    for (int j = 0; j < NS; ++j) {
        const bool eq = k[j] == T; const u64 me = __ballot(eq);
        const bool s = (k[j] > T) || (eq && (eqbase + lanes_below(me)) < need);
        eqbase += popc64(me);
        const u64 ms = __ballot(s);
        sel[j] = s; pos[j] = base + lanes_below(ms); base += popc64(ms);
    }
}
__device__ __forceinline__ float fkey_inv(unsigned k) { return __uint_as_float((k & 0x80000000u) ? (k ^ 0x80000000u) : ~k); }
__device__ __forceinline__ void ce_desc(unsigned& a, unsigned& b) { const unsigned hi = a > b ? a : b, lo = a > b ? b : a; a = hi; b = lo; }
__device__ __forceinline__ void sort16_desc(unsigned (&a)[16]) {
#pragma unroll
    for (int k = 2; k <= 16; k <<= 1)
#pragma unroll
        for (int j = k >> 1; j > 0; j >>= 1)
#pragma unroll
            for (int i = 0; i < 16; ++i) { const int l = i ^ j; if (l > i) { if ((i & k) == 0) ce_desc(a[i], a[l]); else ce_desc(a[l], a[i]); } }
}
__device__ __forceinline__ void merge16_desc(unsigned (&top)[16], const unsigned (&b)[16]) {
#pragma unroll
    for (int i = 0; i < 16; ++i) top[i] = top[i] > b[15 - i] ? top[i] : b[15 - i];
#pragma unroll
    for (int j = 8; j > 0; j >>= 1)
#pragma unroll
        for (int i = 0; i < 16; ++i) { const int l = i ^ j; if (l > i) ce_desc(top[i], top[l]); }
}
constexpr int P5_TB_STRIDE = 36;
constexpr int P5_TB_BYTES = 64 * P5_TB_STRIDE * 4;
constexpr int P5_LIST_OFF = 98304;
static_assert(NWAVES * P5_TB_BYTES <= P5_LIST_OFF && P5_LIST_OFF + 512 * 64 <= RING_BYTES && NEXP * 4 <= P5_LIST_OFF, "top-k phase LDS map");
__device__ __forceinline__ void p5_topk_phase(Frame& F) {
    const int lane = F.lane, tid = F.tid, w = F.wave;
    const float* SC = T_SC(); unsigned char* G8 = T_G8();
    { unsigned char* z0 = G8 + (size_t)F.vcu * 64 * NEXP + (size_t)tid * 16;
#pragma unroll 8
      for (int i = 0; i < (64 * NEXP) / (NWAVES * 64 * 16); ++i) *(GAS v4u*)(z0 + (size_t)i * (NWAVES * 64 * 16)) = (v4u){0u, 0u, 0u, 0u}; }
    {
        LAS float* tb = (LAS float*)(F.lds + RING_OFF + w * P5_TB_BYTES);
        const float* SCw = SC + ((size_t)(F.vcu * NWAVES + w) * 64) * 256;
        const int lp = lane >> 3, lq = lane & 7;
        unsigned S[2][16];
        f32x4 pf[8];
#pragma unroll
        for (int i = 0; i < 8; ++i) pf[i] = *(const GAS f32x4*)(SCw + (size_t)(lp + 8 * i) * 256 + 4 * lq);
#pragma unroll
        for (int p = 0; p < 2; ++p) {
            unsigned top[16];
#pragma unroll
            for (int i = 0; i < 16; ++i) top[i] = 0u;
#pragma unroll 1
            for (int sb = 0; sb < 4; ++sb) {
#pragma unroll
                for (int i = 0; i < 8; ++i) *(LAS f32x4*)(tb + (lp + 8 * i) * P5_TB_STRIDE + 4 * lq) = pf[i];
                { const int nx = p * 4 + sb + 1;
                  if (nx < 8) {
#pragma unroll
                      for (int i = 0; i < 8; ++i) pf[i] = *(const GAS f32x4*)(SCw + (size_t)(lp + 8 * i) * 256 + nx * 32 + 4 * lq); } }
                LDS_WAIT(); asm volatile("" ::: "memory");
#pragma unroll
                for (int hb = 0; hb < 2; ++hb) {
                    unsigned k[16];
#pragma unroll
                    for (int qd = 0; qd < 4; ++qd) { const f32x4 x = *(const LAS f32x4*)(tb + lane * P5_TB_STRIDE + 16 * hb + 4 * qd);
                        const unsigned nb = 127u - (unsigned)(32 * sb + 16 * hb + 4 * qd);
                        k[4 * qd + 0] = (fkey(x.x) & ~127u) | nb; k[4 * qd + 1] = (fkey(x.y) & ~127u) | (nb - 1u); k[4 * qd + 2] = (fkey(x.z) & ~127u) | (nb - 2u); k[4 * qd + 3] = (fkey(x.w) & ~127u) | (nb - 3u); }
                    sort16_desc(k); merge16_desc(top, k);
                }
                LDS_WAIT(); asm volatile("" ::: "memory");
            }
#pragma unroll
            for (int i = 0; i < 16; ++i) S[p][i] = top[i];
        }
        float v0[16], v1[16];
#pragma unroll
        for (int i = 0; i < 16; ++i) { v0[i] = fkey_inv(S[0][i] & ~127u); v1[i] = fkey_inv(S[1][i] & ~127u); }
        unsigned ctop[16];
#pragma unroll
        for (int b = 0; b < 16; ++b) ctop[b] = fkey(v0[0] + v1[b]);
        {
            unsigned kb[16]; int n = 0;
#pragma unroll
            for (int a = 1; a < 16; ++a)
#pragma unroll
                for (int b = 0; b < 16 / (a + 1); ++b) { kb[n & 15] = fkey(v0[a] + v1[b]); ++n;
                    if ((n & 15) == 0) { sort16_desc(kb); merge16_desc(ctop, kb); } }
#pragma unroll
            for (int i = 0; i < 16; ++i) if (i >= (n & 15)) kb[i] = 0u;
            sort16_desc(kb); merge16_desc(ctop, kb);
        }
        const unsigned theta = ctop[15]; const float mx = v0[0] + v1[0];
        float den = 0.f;
#pragma unroll
        for (int a = 0; a < 16; ++a)
#pragma unroll
            for (int b = 0; b < 16 / (a + 1); ++b) { const float sm = v0[a] + v1[b]; den += (fkey(sm) >= theta) ? __expf(sm - mx) : 0.f; }
        const float rden = 1.0f / den;
        LAS unsigned* lst = (LAS unsigned*)(F.lds + RING_OFF + P5_LIST_OFF) + (w * 64 + lane) * 16;
#pragma unroll
        for (int i = 0; i < 4; ++i) *(LAS v4u*)(lst + 4 * i) = (v4u){0u, 0u, 0u, 0u};
        int cnt = 0;
#pragma unroll
        for (int a = 0; a < 16; ++a)
#pragma unroll
            for (int b = 0; b < 16 / (a + 1); ++b) { const float sm = v0[a] + v1[b];
                if (fkey(sm) >= theta && cnt < 16) { const unsigned eid = (127u - (S[0][a] & 127u)) * NKEYS + (127u - (S[1][b] & 127u));
                    lst[cnt] = (f2bf(__expf(sm - mx) * rden) << 16) | eid; ++cnt; } }
    }
    LDS_WAIT();
    __syncthreads();
    unsigned ent[16];
    { const LAS unsigned* lists = (const LAS unsigned*)(F.lds + RING_OFF + P5_LIST_OFF);
#pragma unroll
      for (int r = 0; r < 16; ++r) ent[r] = lists[(4 * r + (tid >> 7)) * 128 + (tid & 127)]; }
    LDS_WAIT(); VM_WAIT();
    __syncthreads();
    for (int u = tid; u < (4 * NEXP * 2) / 16; u += NWAVES * 64) ((LAS v4u*)(F.lds + RING_OFF))[u] = (v4u){0u, 0u, 0u, 0u};
    LDS_WAIT();
    __syncthreads();
    LAS unsigned* row = (LAS unsigned*)(F.lds + RING_OFF + (tid >> 7) * (NEXP * 2));
    unsigned prev_e = 0u, prev_v = 0u;
#pragma unroll
    for (int r = 0; r < 16; ++r) {
        const unsigned e = ent[r], eid = e & 0x3fffu, val = (unsigned)__builtin_rintf(__uint_as_float(e & 0xffff0000u) * 8000.f);
        if (prev_e != 0u) __hip_atomic_fetch_add(row + ((prev_e & 0x3fffu) >> 1), (0u - prev_v) << (16 * (prev_e & 1u)), __ATOMIC_RELAXED, __HIP_MEMORY_SCOPE_WORKGROUP);
        if (e != 0u) __hip_atomic_fetch_add(row + (eid >> 1), val << (16 * (eid & 1u)), __ATOMIC_RELAXED, __HIP_MEMORY_SCOPE_WORKGROUP);
        prev_e = e; prev_v = val;
        LDS_WAIT();
        __syncthreads();
        if (e != 0u) { const unsigned c = eid >> 4;
            const v4u a = *(const LAS v4u*)(row + 8 * c), bq = *(const LAS v4u*)(row + 8 * c + 4);
            constexpr float K = G_SCALE / 8000.f;
            v4u o;
            o.x = pk4_e4m3((float)(a.x & 0xffffu) * K, (float)(a.x >> 16) * K, (float)(a.y & 0xffffu) * K, (float)(a.y >> 16) * K); o.y = pk4_e4m3((float)(a.z & 0xffffu) * K, (float)(a.z >> 16) * K, (float)(a.w & 0xffffu) * K, (float)(a.w >> 16) * K);
            o.z = pk4_e4m3((float)(bq.x & 0xffffu) * K, (float)(bq.x >> 16) * K, (float)(bq.y & 0xffffu) * K, (float)(bq.y >> 16) * K); o.w = pk4_e4m3((float)(bq.z & 0xffffu) * K, (float)(bq.z >> 16) * K, (float)(bq.w & 0xffffu) * K, (float)(bq.w >> 16) * K);
            *(GAS v4u*)(G8 + (size_t)(F.vcu * 64 + 4 * r + (tid >> 7)) * NEXP + 16 * c) = o; }
        LDS_WAIT();
        __syncthreads();
    }
}

__device__ __forceinline__ float v8_scale(const float* gmix, const unsigned* cmax, int lane) {
    float g = 0.f;
#pragma unroll
    for (int i = 0; i < DM / 256; ++i) { const f32x4 a = *(const GAS f32x4*)(gmix + 256 * i + 4 * lane); g = __builtin_fmaxf(g, __builtin_fmaxf(__builtin_fmaxf(__builtin_fabsf(a.x), __builtin_fabsf(a.y)), __builtin_fmaxf(__builtin_fabsf(a.z), __builtin_fabsf(a.w)))); }
    float c = 0.f;
#pragma unroll
    for (int i = 0; i < NKVH * HD / 64; ++i) c = __builtin_fmaxf(c, __uint_as_float(cmax[C_V + 64 * i + lane]));
    const float bound = (float)DM * wave_max(g, lane) * wave_max(c, lane);
    return bound > 0.f ? 448.f / bound : 1.f;
}
__device__ __forceinline__ unsigned v8_pk4(float a, float b, float c, float d) {
    a = __builtin_fminf(__builtin_fmaxf(a, -448.f), 448.f); b = __builtin_fminf(__builtin_fmaxf(b, -448.f), 448.f); c = __builtin_fminf(__builtin_fmaxf(c, -448.f), 448.f); d = __builtin_fminf(__builtin_fmaxf(d, -448.f), 448.f);
    int w = 0; w = __builtin_amdgcn_cvt_pk_fp8_f32(a, b, w, false); w = __builtin_amdgcn_cvt_pk_fp8_f32(c, d, w, true); return (unsigned)w; }
struct P1Order : pg8::StaticOrder {
    const bf16* PROJ; const float* kg; unsigned char* K8; float sk; int wave; unsigned char* V8; float sv;
    __device__ __forceinline__ void vpass(const pg8::Unit& u) const {
        asm volatile("s_waitcnt vmcnt(0)" ::: "memory"); __builtin_amdgcn_s_barrier();
        unsigned z_ = 0u; asm volatile("" : "+v"(z_)); const int lane = (int)__builtin_amdgcn_mbcnt_hi(~0u, __builtin_amdgcn_mbcnt_lo(~0u, z_));
        const int tile = wave >> 1, hd = (u.pn - C_V / 256) * 2 + (wave & 1), t0 = u.pm * 256 + tile * 64, b_ = t0 / SEQ, s0 = t0 & (SEQ - 1);
        const bf16* src = PROJ + (size_t)t0 * IN_COLS + C_V + hd * HD + 2 * lane;
        unsigned char* dst = V8 + ((size_t)(b_ * NKVH + hd) * (SEQ / 64) + (s0 >> 6)) * 8192 + (size_t)(2 * lane) * 64;
        const int x = (lane >> 1) & 3;
#pragma unroll
        for (int c = 0; c < 4; ++c) {
            unsigned lo[4], hi[4];
#pragma unroll
            for (int jj = 0; jj < 4; ++jj) { const int j = 4 * c + jj, k0 = 32 * ((j >> 2) & 1) + 8 * (j & 3) + 4 * (j >> 3);
                const unsigned w0 = *(const GAS unsigned*)(src + (size_t)(k0 + 0) * IN_COLS), w1 = *(const GAS unsigned*)(src + (size_t)(k0 + 1) * IN_COLS), w2 = *(const GAS unsigned*)(src + (size_t)(k0 + 2) * IN_COLS), w3 = *(const GAS unsigned*)(src + (size_t)(k0 + 3) * IN_COLS);
                lo[jj] = v8_pk4(bflo(w0) * sv, bflo(w1) * sv, bflo(w2) * sv, bflo(w3) * sv); hi[jj] = v8_pk4(bfhi(w0) * sv, bfhi(w1) * sv, bfhi(w2) * sv, bfhi(w3) * sv); }
            v4u a; a.x = lo[0]; a.y = lo[1]; a.z = lo[2]; a.w = lo[3]; v4u b; b.x = hi[0]; b.y = hi[1]; b.z = hi[2]; b.w = hi[3];
            *(GAS v4u*)(dst + ((c ^ x) << 4)) = a; *(GAS v4u*)(dst + 64 + ((c ^ x) << 4)) = b;
        }
    }
    __device__ __forceinline__ void done(const pg8::Unit& u) const {
        if (u.pn == C_V / 256 || u.pn == C_V / 256 + 1) { vpass(u); return; }
        if (u.pn != C_K / 256 && u.pn != C_K / 256 + 1) return;
        asm volatile("s_waitcnt vmcnt(0)" ::: "memory"); __builtin_amdgcn_s_barrier();
        unsigned z_ = 0u; asm volatile("" : "+v"(z_)); const int lane = (int)__builtin_amdgcn_mbcnt_hi(~0u, __builtin_amdgcn_mbcnt_lo(~0u, z_));
        const int lp = lane & 15, head = (u.pn - C_K / 256) * 2 + ((lane >> 4) & 1);
        const bool colpart = (lp >> 3) != 0, first = ((lp >> 2) & 1) == 0;
        float inv[8];
#pragma unroll
        for (int e = 0; e < 8; ++e) inv[e] = exp2f(-(float)(8 * (lane & 3) + e) * (13.287712379549449f / 32.0f));
        const f32x4 g0 = *(const GAS f32x4*)(kg + 8 * lp), g1 = *(const GAS f32x4*)(kg + 8 * lp + 4);
        const float gg[8] = {g0.x, g0.y, g0.z, g0.w, g1.x, g1.y, g1.z, g1.w};
#pragma unroll 2
        for (int i = 0; i < 16; ++i) {
            const int t = u.pm * 256 + wave * 32 + 2 * i + (lane >> 5), s = t & (SEQ - 1);
            const float pos = (float)(colpart ? (s & (GRID_W - 1)) : (s / GRID_W));
            float cs[8], sn[8];
#pragma unroll
            for (int e = 0; e < 8; ++e) { const float ang = pos * inv[e]; float rev = ang * 0.15915494309189535f; rev = rev - floorf(rev); cs[e] = __builtin_amdgcn_cosf(rev); sn[e] = __builtin_amdgcn_sinf(rev); }
            const v4u raw = *(const GAS v4u*)(PROJ + (size_t)t * IN_COLS + C_K + head * HD + 8 * lp);
            float y[8]; unpack8(raw, y);
            float ss = 0.f;
#pragma unroll
            for (int e = 0; e < 8; ++e) ss += y[e] * y[e];
            ss += shx(ss, 1, lane); ss += shx(ss, 2, lane); ss += shx(ss, 4, lane); ss += shx(ss, 8, lane);
            const float r = 1.0f / sqrtf(ss * (1.f / HD) + EPS);
            float o[8];
#pragma unroll
            for (int e = 0; e < 8; ++e) y[e] = y[e] * r * gg[e];
#pragma unroll
            for (int e = 0; e < 8; ++e) { const float pr = shx(y[e], 4, lane); o[e] = y[e] * cs[e] + (first ? -pr : pr) * sn[e]; }
            const int b_ = t / SEQ;
            float y6[32];
#pragma unroll
            for (int j = 0; j < 4; ++j)
#pragma unroll
                for (int e = 0; e < 8; ++e) y6[8 * j + e] = __builtin_bit_cast(float, __builtin_amdgcn_ds_bpermute(((lane & ~3) + j) << 2, __builtin_bit_cast(int, o[e])));
            if ((lane & 3) == 0) { const pg8::i32x6 w = cvt32_fp6(y6, sk); unsigned char* dst = K8 + ((size_t)(b_ * NKVH + head) * SEQ + s) * HD + 32 * (lp >> 2);
                v4u a; a.x = (unsigned)w[0]; a.y = (unsigned)w[1]; a.z = (unsigned)w[2]; a.w = (unsigned)w[3]; *(GAS v4u*)dst = a; *(GAS u64*)(dst + 16) = (u64)(unsigned)w[4] | ((u64)(unsigned)w[5] << 32); }
        }
    }
};

__global__ void __launch_bounds__(NWAVES * 64, 2) hymba_fwd(Args args) {
    extern __shared__ __attribute__((aligned(16))) unsigned char lds[];
    Frame F;
    F.lds = (LAS unsigned char*)lds;
    F.MISC = (volatile LAS unsigned*)(F.lds + MISC_OFF);
    F.wave = __builtin_amdgcn_readfirstlane((int)threadIdx.x >> 6);
#define FRESH_IDS() do { unsigned z_ = 0u; asm volatile("" : "+v"(z_));   \
        const int t_ = (F.wave << 6) | (int)__builtin_amdgcn_mbcnt_hi(~0u, __builtin_amdgcn_mbcnt_lo(~0u, z_)); F.tid = t_; F.lane = t_ & 63; } while (0)
    FRESH_IDS();
    F.G = gridDim.x;
    for (int u = F.tid; u < (LDS_BYTES - LDSCTL_OFF) / 4; u += NWAVES * 64) ((LAS unsigned*)(F.lds + LDSCTL_OFF))[u] = 0u;
    __syncthreads();
    { const int bx = (int)blockIdx.x; F.vcu = (F.G % 8 == 0) ? (bx % 8) * (F.G / 8) + bx / 8 : bx; F.cid = bx; }
    XcdBarrier bar = xcd_barrier_post((unsigned*)(kws() + WS_CTL) + CW_BAR, F.MISC + 8);
#define GRID_BAR() do { xcd_barrier(bar); FRESH_IDS(); } while (0)
    const int gw = F.vcu * NWAVES + F.wave, NGW = F.G * NWAVES;
    const int nph = *(const CAS4 int*)(kargs() + 136);

    p0a_absmax(F);
    GRID_BAR();
    if (F.tid == 0) { const float* sp_ = T_SCALES(); F.MISC[16] = __float_as_uint(peer_scale(sp_, 0)); F.MISC[17] = __float_as_uint(peer_scale(sp_, 1)); F.MISC[18] = __float_as_uint(peer_scale(sp_, 2)); }
    p0_prologue(F);
#if defined(HY_PROBE_P0)
    GRID_BAR(); p0_prologue(F); GRID_BAR(); p0_prologue(F);
#endif
    GRID_BAR();
    {
        pg8::Gemm g{(const bf16*)T_HI8(), (const bf16*)T_WIN8(), M, IN_COLS, DM / 2}; P1Order S; S.init(M, IN_COLS, F.G, F.cid);
        S.PROJ = T_PROJ(); S.kg = T_k_norm_g(); S.K8 = T_K8(); S.sk = 7.5f / k8_max(T_k_norm_g(), F.lane); S.wave = F.wave; S.V8 = T_V8(); S.sv = v8_scale(T_norm_mix_g(), T_CMAX(), F.lane);
        pg8::EpiBf16I8 E{T_PROJ(), IN_COLS, T_RSA(), (const float*)T_CMAX()};
        pg8::gemm_phase<pg8::EpiBf16I8, P1Order, true, true, 2>(F.lds + RING_OFF, g, S, E, F.wave);
#if defined(HY_PROBE_P1)
        __syncthreads(); pg8::gemm_phase<pg8::EpiBf16I8, pg8::StaticOrder, true, true, 2>(F.lds + RING_OFF, g, S, E, F.wave);
#endif
    }
    GRID_BAR();
#define HY_SIDE() do { side_weight_copies(F); { const bf16* PROJ_ = T_PROJ(); unsigned char* Y8_ = T_YI8(); float* mxc_ = T_MXC(); const float* cw_ = T_conv_w(); const float* cg_ = T_conv_out_g(); \
        const int gw_ = F.vcu * NWAVES + F.wave, tpw_ = M / (F.G * NWAVES); p2_conv_run(F, gw_ * tpw_, tpw_, PROJ_, Y8_, mxc_, cw_, cg_); } } while (0)
#define HY_ATTN_UNIT(i, NOSH) do { int L_; if (F.G == 256) L_ = (F.vcu >> 5) * 128 + (i) * 32 + (F.vcu & 31); else L_ = (i) * F.G + F.vcu; \
        if (L_ < BATCH * NQH * (SEQ / 256)) { const int bkv = L_ >> 7, rem = L_ & 127, b = bkv >> 2, kvh = bkv & 3, h = kvh * 4 + (rem >> 5), qb = rem & 31; const size_t rowb = (size_t)b * SEQ; \
            attn128::attn_dense_body<attn128::bf16, false, true, true, true>(P + (rowb + (size_t)qb * 256) * IN_COLS + C_Q + h * HD, (const attn128::bf16*)(K8a + (size_t)bkv * SEQ * HD), (const attn128::bf16*)(V8a + (size_t)bkv * SEQ * HD), \
                                                     Yb + (rowb + (size_t)qb * 256) * DM + h * HD, SEQ, (char*)lds + RING_OFF, F.wave, qgain, qb * 256, kinv, vinv); } } while (0)
    if (nph > 3) {
        const attn128::bf16* P = (const attn128::bf16*)T_PROJ(); attn128::bf16* Yb = (attn128::bf16*)T_Y(); const float* qgain = T_q_norm_g();
        const unsigned char* K8a = T_K8(); const unsigned char* V8a = T_V8(); const float vinv = 1.0f / v8_scale(T_norm_mix_g(), T_CMAX(), F.lane); const float kinv = k8_max(T_k_norm_g(), F.lane) * (1.f / 7.5f);
        const int nun = (F.G == 256) ? 4 : (BATCH * NQH * (SEQ / 256) + F.G - 1) / F.G, k0 = (F.G == 256) ? (F.vcu & 3) : 0;
        int i = 0;
#pragma unroll 1
        for (; i < k0; ++i) HY_ATTN_UNIT(i, false);
        HY_SIDE();
#pragma unroll 1
        for (; i < nun; ++i) HY_ATTN_UNIT(i, false);
        __syncthreads();
    } else HY_SIDE();
#undef HY_ATTN_UNIT
#undef HY_SIDE
    GRID_BAR();
    { const bf16* Y = T_Y(); unsigned char* YI8 = T_YI8(); const float* mxc = T_MXC(); float* rs = T_RSA(); float* rho = T_RHO(); for (int t = gw; t < M; t += NGW) p3b_quant_token(F, t, Y, YI8, mxc, rs, rho); }
    { const bf16* wsc = T_WSC(); unsigned char* w8 = T_WSC8(); float* cm = T_CMAXW(); for (int j = gw; j < PQ; j += NGW) wsc_quant_row(wsc + (size_t)j * DM, w8 + (size_t)j * DM, cm + j, F.lane); }
    GRID_BAR();
    {
        pg8::Gemm g{(const bf16*)T_YI8(), T_WOUT(), M, DM, DM / 2}; pg8::StaticOrder S; S.init(M, DM, F.G, F.cid);
        pg8::EpiResBf16I8 E{T_XB(), T_X1B(), DM, T_RSA(), (const float*)T_CMAXO(), T_RHO()};
        pg8::gemm_phase<pg8::EpiResBf16I8, pg8::StaticOrder, true, true, 2, true>(F.lds + RING_OFF, g, S, E, F.wave);
    }
    GRID_BAR();
    if (nph > 5) {
    { const bf16* x1 = T_X1B(); const float* g = T_norm_ffn_g(); float* rs2 = T_RS2(); unsigned char* H8 = T_H8(); unsigned char* X18 = T_X1I8();
      const float h6s = PEER_SCALE(2);
      for (int m = gw; m < M; m += NGW) rms_rowb_to_h2(x1 + (size_t)m * DM, g, rs2 + m, H8, m, F.lane, X18 + (size_t)m * DM, h6s); }
    GRID_BAR();
    {
        pg8::Gemm g{(const bf16*)T_X1I8(), (const bf16*)T_WSC8(), M, PQ, DM / 2}; pg8::StaticOrder S; S.init(M, PQ, F.G, F.cid);
        pg8::EpiF32PlainI8 E{T_SC(), PQ, T_RS2(), T_CMAXW()};
        pg8::gemm_phase<pg8::EpiF32PlainI8, pg8::StaticOrder, true, true, 2>(F.lds + RING_OFF, g, S, E, F.wave);
#if defined(HY_PROBE_P5A)
        __syncthreads(); pg8::gemm_phase<pg8::EpiF32Plain, pg8::StaticOrder, true, true>(F.lds + RING_OFF, g, S, E, F.wave);
#endif
    }
    GRID_BAR();
    p5_topk_phase(F);
#if defined(HY_PROBE_P5)
    GRID_BAR(); p5_topk_phase(F); GRID_BAR(); p5_topk_phase(F); GRID_BAR(); p5_topk_phase(F);
#endif
    GRID_BAR();
    {
        pg8::Gemm g{(const bf16*)T_H8(), (const bf16*)T_WD8(), M, NEXP, DM / 2}; pg8::StaticOrder S; S.init(M, NEXP, F.G, F.cid);
        pg8::EpiGeluGate8 E{T_G8(), NEXP, 1.0f / (PEER_SCALE(2) * PEER_SCALE(0))};
#if defined(HY_PROBE_P6)
        { pg8::EpiNull EN; pg8::gemm_phase<pg8::EpiNull, pg8::StaticOrder, true, true, 1>(F.lds + RING_OFF, g, S, EN, F.wave); __syncthreads(); }
#endif
        pg8::gemm_phase_fp6p<pg8::EpiGeluGate8, pg8::StaticOrder>(F.lds + RING_OFF, T_H8(), T_WD8(), S, E, F.wave);
    }
    GRID_BAR();
    {
        pg8::Gemm g{(const bf16*)T_G8(), (const bf16*)T_WUP8(), M, DM, NEXP / 2}; pg8::StaticOrder S; S.init(M, DM, F.G, F.cid);
        pg8::EpiResBf16 E{T_X1B(), T_X2B(), DM, 1.0f / (G_SCALE * PEER_SCALE(1)), nullptr};
#if defined(HY_PROBE_P7)
        { pg8::EpiNull EN; pg8::gemm_phase<pg8::EpiNull, pg8::StaticOrder, true, true, 1>(F.lds + RING_OFF, g, S, EN, F.wave); __syncthreads(); }
#endif
#if defined(HY_PROBE_P7L2)
        { struct SameTile : pg8::StaticOrder { __device__ bool next(int i, pg8::Unit& u) const { pg8::Unit t; const bool ok = pg8::StaticOrder::next(i, t); u.pm = 0; u.pn = 0; return ok; } } S2; S2.init(M, DM, F.G, F.cid);
          pg8::EpiNull EN; pg8::gemm_phase<pg8::EpiNull, SameTile, true, true, 1>(F.lds + RING_OFF, g, S2, EN, F.wave); __syncthreads(); }
#endif
        pg8::gemm_phase<pg8::EpiResBf16, pg8::StaticOrder, true, true, 1>(F.lds + RING_OFF, g, S, E, F.wave);
    }
    GRID_BAR();
    }
    if (nph > 5) { const bf16* x2 = T_X2B(); float* o_ = kout(); const float* g = T_norm_final_g();
      for (int m = gw; m < M; m += NGW) rms_rowb_to_f32(x2 + (size_t)m * DM, g, o_ + (size_t)m * DM, F.lane); }
#undef GRID_BAR
}


#ifndef HY_NPHASE
#define HY_NPHASE 9
#endif
extern "C" void kernel_launch(void* const* d_in, const int* in_sizes, int n_in, void* d_out, int out_size, void* d_ws, size_t ws_size, hipStream_t stream) {
    static int grid = 0;
    if (grid == 0) {
        if (n_in != 15 || in_sizes[0] != M * DM || out_size != M * DM || ws_size < WS_END) {
            fprintf(stderr, "kernel_launch: built for 15 inputs, x/out of %d floats, >= %zu bytes of workspace; got n_in %d, in0 %d, out %d, ws %zu; nothing launched\n", M * DM, (size_t)WS_END, n_in, n_in > 0 ? in_sizes[0] : -1, out_size, ws_size);
            grid = -1; return; }
        int dev = 0, cus = 0, per_cu = 0;
        if (hipGetDevice(&dev) != hipSuccess || hipDeviceGetAttribute(&cus, hipDeviceAttributeMultiprocessorCount, dev) != hipSuccess) { fprintf(stderr, "kernel_launch: device query failed\n"); grid = -1; return; }
        if (hipFuncSetAttribute((const void*)hymba_fwd, hipFuncAttributeMaxDynamicSharedMemorySize, LDS_BYTES) != hipSuccess) { fprintf(stderr, "kernel_launch: hipFuncSetAttribute failed\n"); grid = -1; return; }
        if (hipOccupancyMaxActiveBlocksPerMultiprocessor(&per_cu, (const void*)hymba_fwd, NWAVES * 64, LDS_BYTES) != hipSuccess || per_cu < 1)
            fprintf(stderr, "kernel_launch: note: occupancy query reports %d workgroups per CU\n", per_cu);
        (void)hipGetLastError();
        if (cus < 256) { fprintf(stderr, "kernel_launch: built for a 256-CU device (one workgroup per CU, all resident); this one reports %d; nothing launched\n", cus); grid = -1; return; }
        grid = 256;
    }
    if (grid < 0) return;
    if (hipMemsetAsync((char*)d_ws + WS_CTL, 0, CTL_ZERO_BYTES, stream) != hipSuccess) { fprintf(stderr, "kernel_launch: hipMemsetAsync failed\n"); return; }
    Args a{};
    for (int i = 0; i < 15; ++i) a.in[i] = (const float*)d_in[i];
    a.out = (float*)d_out; a.ws = (unsigned char*)d_ws; a.nphase = HY_NPHASE; a.pad = 0;
    hipLaunchKernelGGL(hymba_fwd, dim3(grid), dim3(NWAVES * 64), LDS_BYTES, stream, a);
    const hipError_t le = hipPeekAtLastError();
    if (le != hipSuccess) fprintf(stderr, "kernel_launch: launch failed: %s\n", hipGetErrorName(le));
}
```
